# Optimizing an MI355X kernel written in HIP

```python
import math
import jax, jax.numpy as jnp
from jax import lax
import numpy as np


D_MODEL = 1024
BATCH = 8
SEQ = 4096
DEPTH = 2
DEC_BATCH = 4
DEC_SEQ = 4096
PAST_LEN = 128

GROUP_DIM = 128
MIX_WIDTH = D_MODEL
RET_HEADS = 4
RET_DK = 128
RET_DV = 128
RET_WIDTH = RET_HEADS * RET_DV
RET_CHUNK = 128
ROPE_BASE = 10000.0
CONV_WIDTH = MIX_WIDTH - RET_WIDTH
CONV_K = 3
FOURIER_GROUPS = 4
FOURIER_WIDTH = FOURIER_GROUPS * GROUP_DIM
SGU_GROUPS = 4
SGU_WIDTH = SGU_GROUPS * GROUP_DIM
SGU_CHUNK = 128
D_FF = 2816
AB_IN = 4 * RET_WIDTH + 3 * CONV_WIDTH
CD_IN = FOURIER_WIDTH + 2 * SGU_WIDTH
N_EVEN = (DEPTH + 1) // 2
N_ODD = DEPTH // 2
DN_ALPHA = (2.0 * DEPTH) ** 0.25
DN_BETA = (8.0 * DEPTH) ** -0.25
LN_EPS = 1e-5

kernel_name = 'hybrid_retention_conv_fourier_sgu_encoder'


def _layer_norm(x, g, b):
    xf = x.astype(jnp.float32)
    mu = jnp.mean(xf, -1, keepdims=True)
    var = jnp.mean(jnp.square(xf - mu), -1, keepdims=True)
    y = (xf - mu) * lax.rsqrt(var + LN_EPS) * g.astype(jnp.float32) + b.astype(jnp.float32)
    return y.astype(x.dtype)


def _swiglu(x, wg, wu, wd):
    return (jax.nn.silu(x @ wg) * (x @ wu)) @ wd


def _rotary(t, cos, sin):
    t1, t2 = jnp.split(t, 2, axis=-1)
    return jnp.concatenate([t1 * cos - t2 * sin, t2 * cos + t1 * sin], axis=-1)


def _retention_one_direction(q, k, v, log_gamma, include_diag):
    bsz, s, h, dk = q.shape
    dv = v.shape[-1]
    c = RET_CHUNK
    n = s // c

    def chunks(t):
        return t.reshape(bsz, n, c, h, t.shape[-1]).transpose(1, 0, 3, 2, 4)

    idx = jnp.arange(c, dtype=jnp.float32)
    diff = idx[:, None] - idx[None, :]
    mask = (diff >= 0) if include_diag else (diff > 0)
    intra = jnp.where(mask, jnp.exp(log_gamma[:, None, None] * jnp.maximum(diff, 0.0)), 0.0)
    q_decay = jnp.exp(log_gamma[:, None] * (idx + 1.0))[..., None]
    k_decay = jnp.exp(log_gamma[:, None] * (c - 1.0 - idx))[..., None]
    chunk_decay = jnp.exp(log_gamma * c)[:, None, None]

    def step(state, qkv):
        qc, kc, vc = qkv
        scores = jnp.einsum('bhid,bhjd->bhij', qc, kc) * intra
        out = (jnp.einsum('bhij,bhjv->bhiv', scores, vc)
               + jnp.einsum('bhid,bhdv->bhiv', qc * q_decay, state))
        state = state * chunk_decay + jnp.einsum('bhjd,bhjv->bhdv', kc * k_decay, vc)
        return state, out

    state0 = jnp.zeros((bsz, h, dk, dv), jnp.float32)
    _, out = lax.scan(step, state0, (chunks(q), chunks(k), chunks(v)))
    return out.transpose(1, 0, 3, 2, 4).reshape(bsz, s, h, dv)


def _mixer_retention_conv(x, w_in, w_out, decay_fwd, decay_bwd, conv_w):
    bsz, s, _ = x.shape
    proj = x @ w_in
    q, k, v, g, gate_b, gate_c, hc = jnp.split(
        proj, [RET_WIDTH, 2 * RET_WIDTH, 3 * RET_WIDTH, 4 * RET_WIDTH,
               4 * RET_WIDTH + CONV_WIDTH, 4 * RET_WIDTH + 2 * CONV_WIDTH], axis=-1)
    pos = jnp.arange(s, dtype=jnp.float32)
    inv_freq = ROPE_BASE ** (-jnp.arange(0, RET_DK, 2, dtype=jnp.float32) / RET_DK)
    ang = pos[:, None] * inv_freq[None, :]
    cos = jnp.cos(ang)[:, None, :]
    sin = jnp.sin(ang)[:, None, :]
    qh = _rotary(q.reshape(bsz, s, RET_HEADS, RET_DK).astype(jnp.float32), cos, sin)
    kh = _rotary(k.reshape(bsz, s, RET_HEADS, RET_DK).astype(jnp.float32), cos, sin) * (RET_DK ** -0.5)
    vh = v.reshape(bsz, s, RET_HEADS, RET_DV).astype(jnp.float32)
    lg_f = jax.nn.log_sigmoid(decay_fwd.astype(jnp.float32))
    lg_b = jax.nn.log_sigmoid(decay_bwd.astype(jnp.float32))
    o_fwd = _retention_one_direction(qh, kh, vh, lg_f, True)
    o_bwd = jnp.flip(_retention_one_direction(jnp.flip(qh, 1), jnp.flip(kh, 1), jnp.flip(vh, 1), lg_b, False), 1)
    o = o_fwd + o_bwd
    mu = jnp.mean(o, -1, keepdims=True)
    var = jnp.mean(jnp.square(o - mu), -1, keepdims=True)
    o = ((o - mu) * lax.rsqrt(var + LN_EPS)).reshape(bsz, s, RET_WIDTH).astype(x.dtype)
    ret_out = jax.nn.silu(g) * o
    z = gate_c * hc
    zp = jnp.pad(z, ((0, 0), (1, 1), (0, 0)))
    conv = conv_w[0] * zp[:, :-2] + conv_w[1] * zp[:, 1:-1] + conv_w[2] * zp[:, 2:]
    conv_out = gate_b * conv
    return jnp.concatenate([ret_out, conv_out], axis=-1) @ w_out


def _mixer_fourier_sgu(x, w_in, w_out, sgu_ln_g, sgu_ln_b, sgu_w, sgu_b):
    bsz, s, _ = x.shape
    proj = x @ w_in
    f_in, u, v = jnp.split(proj, [FOURIER_WIDTH, FOURIER_WIDTH + SGU_WIDTH], axis=-1)
    f = f_in.reshape(bsz, s, FOURIER_GROUPS, GROUP_DIM).astype(jnp.float32)
    f_out = jnp.real(jnp.fft.fft2(f, axes=(1, 3), norm='ortho')).reshape(bsz, s, FOURIER_WIDTH).astype(x.dtype)
    u = jax.nn.gelu(u)
    v = _layer_norm(jax.nn.gelu(v), sgu_ln_g, sgu_ln_b)
    vc = v.reshape(bsz, s // SGU_CHUNK, SGU_CHUNK, SGU_GROUPS, GROUP_DIM)
    sg = jnp.einsum('gij,bnjgc->bnigc', sgu_w, vc) + sgu_b.T[:, :, None]
    d_out = u * sg.reshape(bsz, s, SGU_WIDTH)
    return jnp.concatenate([f_out, d_out], axis=-1) @ w_out


def _trunk(x, ffn_w_gate, ffn_w_up, ffn_w_down, ln_g, ln_b, ab_w_in, ab_w_out, ret_decay_fwd,
           ret_decay_bwd, conv_w, cd_w_in, cd_w_out, sgu_ln_g, sgu_ln_b, sgu_w, sgu_b):
    for layer in range(DEPTH):
        ffn1 = _swiglu(x, ffn_w_gate[layer, 0], ffn_w_up[layer, 0], ffn_w_down[layer, 0])
        x = _layer_norm(DN_ALPHA * x + 0.5 * ffn1, ln_g[layer, 0], ln_b[layer, 0])
        i = layer // 2
        if layer % 2 == 0:
            mix = _mixer_retention_conv(x, ab_w_in[i], ab_w_out[i], ret_decay_fwd[i], ret_decay_bwd[i], conv_w[i])
        else:
            mix = _mixer_fourier_sgu(x, cd_w_in[i], cd_w_out[i], sgu_ln_g[i], sgu_ln_b[i], sgu_w[i], sgu_b[i])
        x = _layer_norm(DN_ALPHA * x + mix, ln_g[layer, 1], ln_b[layer, 1])
        ffn2 = _swiglu(x, ffn_w_gate[layer, 1], ffn_w_up[layer, 1], ffn_w_down[layer, 1])
        x = _layer_norm(DN_ALPHA * x + 0.5 * ffn2, ln_g[layer, 2], ln_b[layer, 2])
    return x


def setup_inputs(seed: int = 0) -> dict:
    key = jax.random.key(seed)
    ks = jax.random.split(key, 20)
    f32 = jnp.float32
    nrm = lambda k, shape, scale: jax.random.normal(k, shape, f32) * scale
    heads = jnp.arange(RET_HEADS, dtype=f32)
    decay_base = jnp.log(2.0 ** (5.0 + heads) - 1.0)
    return {
        'x_prompt': nrm(ks[0], (BATCH, SEQ, D_MODEL), 1.0),
        'x_sample': nrm(ks[1], (DEC_BATCH, DEC_SEQ, D_MODEL), 1.0),
        'ffn_w_gate': nrm(ks[2], (DEPTH, 2, D_MODEL, D_FF), D_MODEL ** -0.5),
        'ffn_w_up': nrm(ks[3], (DEPTH, 2, D_MODEL, D_FF), D_MODEL ** -0.5),
        'ffn_w_down': nrm(ks[4], (DEPTH, 2, D_FF, D_MODEL), DN_BETA * D_FF ** -0.5),
        'ln_g': 1.0 + nrm(ks[5], (DEPTH, 3, D_MODEL), 0.02),
        'ln_b': nrm(ks[6], (DEPTH, 3, D_MODEL), 0.02),
        'ab_w_in': nrm(ks[7], (N_EVEN, D_MODEL, AB_IN), D_MODEL ** -0.5),
        'ab_w_out': nrm(ks[8], (N_EVEN, MIX_WIDTH, D_MODEL), DN_BETA * MIX_WIDTH ** -0.5),
        'ret_decay_fwd': decay_base[None, :] + nrm(ks[9], (N_EVEN, RET_HEADS), 0.1),
        'ret_decay_bwd': decay_base[None, :] + nrm(ks[10], (N_EVEN, RET_HEADS), 0.1),
        'conv_w': nrm(ks[11], (N_EVEN, CONV_K, CONV_WIDTH), CONV_K ** -0.5),
        'cd_w_in': nrm(ks[12], (N_ODD, D_MODEL, CD_IN), D_MODEL ** -0.5),
        'cd_w_out': nrm(ks[13], (N_ODD, MIX_WIDTH, D_MODEL), DN_BETA * MIX_WIDTH ** -0.5),
        'sgu_ln_g': 1.0 + nrm(ks[14], (N_ODD, SGU_WIDTH), 0.02),
        'sgu_ln_b': nrm(ks[15], (N_ODD, SGU_WIDTH), 0.02),
        'sgu_w': nrm(ks[16], (N_ODD, SGU_GROUPS, SGU_CHUNK, SGU_CHUNK), SGU_CHUNK ** -0.5),
        'sgu_b': 1.0 + nrm(ks[17], (N_ODD, SGU_GROUPS, SGU_CHUNK), 0.02),
    }


def reference(x_prompt, x_sample, ffn_w_gate, ffn_w_up, ffn_w_down, ln_g, ln_b, ab_w_in, ab_w_out,
              ret_decay_fwd, ret_decay_bwd, conv_w, cd_w_in, cd_w_out, sgu_ln_g, sgu_ln_b, sgu_w, sgu_b):
    y_prompt = _trunk(x_prompt, ffn_w_gate, ffn_w_up, ffn_w_down, ln_g, ln_b, ab_w_in, ab_w_out,
                      ret_decay_fwd, ret_decay_bwd, conv_w, cd_w_in, cd_w_out, sgu_ln_g, sgu_ln_b, sgu_w, sgu_b)
    y_sample = _trunk(x_sample, ffn_w_gate, ffn_w_up, ffn_w_down, ln_g, ln_b, ab_w_in, ab_w_out,
                      ret_decay_fwd, ret_decay_bwd, conv_w, cd_w_in, cd_w_out, sgu_ln_g, sgu_ln_b, sgu_w, sgu_b)
    return (y_prompt, y_sample)
```

```cpp
#include <hip/hip_runtime.h>
#include <hip/hip_cooperative_groups.h>
#include <cstdio>
#include <cstdint>
namespace cg = cooperative_groups;


#define DI __device__ __forceinline__
#define LAS __attribute__((address_space(3)))
typedef unsigned short bf16_t;
typedef short bf16x8 __attribute__((ext_vector_type(8)));
typedef short s16x4 __attribute__((ext_vector_type(4)));
typedef float f32x4 __attribute__((ext_vector_type(4)));
typedef float f32x2 __attribute__((ext_vector_type(2)));
typedef unsigned u32x4 __attribute__((ext_vector_type(4)));
typedef unsigned u32x2 __attribute__((ext_vector_type(2)));

constexpr int T = 49152, TP = 32768, D = 1024, FF = 2816, SEQ = 4096;
constexpr int ABN = 3584;
constexpr int SLAB = 16384;
constexpr float DN_ALPHA = 1.41421356237309515f;
constexpr float LN_EPS = 1e-5f;
constexpr float KSCALE = 0.08838834764831845f;
constexpr float FSCALE = 0.0013810679320049757f;
constexpr int VTS = 17424;
constexpr int LDS_MISC = 4 * VTS * 2;
constexpr int LDS_LNP = 131072;
constexpr int LDS_LNS = LDS_MISC + 1024;
constexpr int LDS_BYTES = LDS_MISC + 1024 + 2048;
constexpr int NPHASE = 31;

constexpr size_t SZ_WGU = (size_t)5632 * 1024 * 2, SZ_WD = (size_t)1024 * 2816 * 2, SZ_SQ = (size_t)1024 * 1024 * 2;
constexpr size_t WS_WGU = 0;
constexpr size_t WS_WD = WS_WGU + 4 * SZ_WGU;
constexpr size_t WS_WABI = WS_WD + 4 * SZ_WD;
constexpr size_t WS_WABO = WS_WABI + (size_t)ABN * 1024 * 2;
constexpr size_t WS_WF1 = WS_WABO + SZ_SQ;
constexpr size_t WS_WUV = WS_WF1 + SZ_SQ;
constexpr size_t WS_WCDO = WS_WUV + SZ_SQ;
constexpr size_t WS_SGUW = WS_WCDO + SZ_SQ;
constexpr size_t WS_DFT = WS_SGUW + (size_t)4 * 128 * 128 * 2;
constexpr size_t WS_ROPE = WS_DFT + (size_t)4096 * 8192 * 2;
constexpr size_t WS_XB = WS_ROPE + (size_t)2 * 4096 * 64 * 4;
constexpr size_t WS_S = WS_XB + (size_t)T * D * 2;
constexpr size_t S_H = 0;
constexpr size_t S_PJ = 0;
constexpr size_t S_KV = S_PJ + (size_t)SLAB * ABN * 2;
constexpr size_t S_ST = S_KV + (size_t)512 * 2 * 16384 * 4;
constexpr size_t S_GT = 0;
constexpr size_t S_UV = S_GT + (size_t)6144 * 8192 * 2;
constexpr size_t S_F2P = S_UV + (size_t)T * D * 2;
constexpr size_t WS_BAR = WS_S + (size_t)T * FF * 2;
constexpr size_t WS_LNS = WS_BAR + 16384;
constexpr size_t SZ_LNS = (size_t)T * 4 * 8;
constexpr size_t WS_LNC = WS_LNS + SZ_LNS;
constexpr size_t WS_END = WS_LNC + 6 * 1024;
constexpr size_t ZERO_BYTES = 16384;
constexpr size_t ZERO2_BYTES = SZ_LNS;

typedef __bf16 hwbf16x2 __attribute__((ext_vector_type(2)));
DI unsigned pk2(float lo, float hi) { const f32x2 v = {lo, hi}; return __builtin_bit_cast(unsigned, __builtin_convertvector(v, hwbf16x2)); }
DI unsigned short f2bf(float f) { return (unsigned short)(pk2(f, 0.f) & 0xffffu); }
DI float bf2f(unsigned short b) { return __uint_as_float(((unsigned)b) << 16); }
DI float bflo(unsigned w) { return __uint_as_float(w << 16); }
DI float bfhi(unsigned w) { return __uint_as_float(w & 0xffff0000u); }
#define LDS_WAIT() asm volatile("s_waitcnt lgkmcnt(0)" ::: "memory")

namespace pg8 {
constexpr int BM = 256, BK = 64, HALF = 128, HTB = HALF * BK * 2, STAGE_BYTES = 8 * HTB, NXCD = 8, WGM = 8;
__host__ __device__ __forceinline__ int lds_byte(int r, int c) { const int st = (r >> 4) * 2 + (c >> 5), rr = r & 15, cc = c & 31, ob = rr * 64 + cc * 2; return st * 1024 + (ob ^ (((ob >> 9) & 1) << 5)); }
__host__ __device__ __forceinline__ void stage_rc(int b, int& R, int& C) { const int st = b / 1024, sb = b % 1024, swz = sb ^ (((sb >> 9) & 1) << 5); R = (st >> 1) * 16 + swz / 64; C = (st & 1) * 32 + (swz % 64) / 2; }
__host__ __device__ __forceinline__ int perm32(int rho) { const int n = rho >> 4, i = rho & 15; return 8 * (i >> 2) + 4 * n + (i & 3); }
struct Unit { int pm, pn; };
struct Gemm { const bf16_t* A; const bf16_t* Bt; int M, N, K, lda, ldb; };
struct StaticOrder {
    int nM, nN, nwg, G, c, pnfast;
    __device__ void init(int M, int N, int G_, int c_, int pnfast_ = 0) { nM = M / BM; nN = N / BM; nwg = nM * nN; G = G_; c = c_; pnfast = pnfast_; }
    __device__ bool next(int i, Unit& u) const {
        const long L = (long)i * G + c; if (L >= nwg) return false;
        int wgid = (int)L; { const int q = nwg / NXCD, r = nwg % NXCD, xcd = wgid % NXCD, off = wgid / NXCD; wgid = (xcd < r ? xcd * (q + 1) : r * (q + 1) + (xcd - r) * q) + off; }
        const int nig = WGM * nN, gid = wgid / nig, fm = gid * WGM, gsz = (nM - fm) < WGM ? (nM - fm) : WGM;
        if (pnfast) { u.pn = (wgid % nig) % nN; u.pm = fm + (wgid % nig) / nN; }
        else { u.pm = fm + ((wgid % nig) % gsz); u.pn = (wgid % nig) / gsz; }
        return true;
    }
    __device__ size_t boff(const Unit&) const { return 0; }
};
struct F2Order {
    int G, c;
    __device__ bool next(int i, Unit& u) const { const int su = c + (i >> 1) * G; if (su >= 192) return false; u.pm = (su & 7) + 8 * (i & 1); u.pn = su >> 3; return true; }
    __device__ size_t boff(const Unit& u) const { return u.pm >= 8 ? (size_t)4096 * 2 : 0; }
};
DI unsigned cvt_pk_bf16(float lo, float hi) { unsigned r; asm volatile("v_cvt_pk_bf16_f32 %0, %1, %2" : "=v"(r) : "v"(lo), "v"(hi)); return r; }

DI float silu_f(float g) { return g * __builtin_amdgcn_rcpf(1.0f + __expf(-g)); }
DI f32x4 swiglu4(f32x4 g, f32x4 u) {
    f32x4 t = g * (-1.4426950408889634f), e;
#pragma unroll
    for (int i = 0; i < 4; ++i) e[i] = __builtin_amdgcn_exp2f(fminf(t[i], 30.0f));
    const f32x4 a = e + 1.0f;
    const float P = a[0] * a[1], Q = a[2] * a[3], R = __builtin_amdgcn_rcpf(P * Q), QR = Q * R, PR = P * R;
    const f32x4 inv = {a[1] * QR, a[0] * QR, a[3] * PR, a[2] * PR};
    return g * u * inv;
}
DI float gelu_tanh_f(float x) { const float y = 0.7978845608028654f * (x + 0.044715f * x * x * x); return x * __builtin_amdgcn_rcpf(1.0f + __expf(-2.0f * y)); }

struct EpiSwiglu {
    static constexpr bool PERM = true, ALIGN = false;
    bf16_t* H;
    DI void operator()(const f32x4 (&acc)[2][2][4][2], const Unit& u, int wr, int wc, int fr, int fq) const {
        const int row0 = u.pm * BM + wr * 64 + fr, col0 = u.pn * 128 + wc * 32 + 8 * fq;
#pragma unroll
        for (int ai = 0; ai < 2; ++ai)
#pragma unroll
            for (int m = 0; m < 4; ++m) {
                bf16_t* rowp = H + (size_t)(row0 + ai * HALF + m * 16) * FF + col0;
                const f32x4 h0 = swiglu4(acc[ai][0][m][0], acc[ai][1][m][0]), h1 = swiglu4(acc[ai][0][m][1], acc[ai][1][m][1]);
                u32x4 w; w.x = cvt_pk_bf16(h0[0], h0[1]); w.y = cvt_pk_bf16(h0[2], h0[3]); w.z = cvt_pk_bf16(h1[0], h1[1]); w.w = cvt_pk_bf16(h1[2], h1[3]);
                *(u32x4*)rowp = w;
            }
    }
};
template <int ACT> struct EpiBf16 {
    static constexpr bool PERM = true, ALIGN = false;
    bf16_t* O; int ldc;
    DI void operator()(const f32x4 (&acc)[2][2][4][2], const Unit& u, int wr, int wc, int fr, int fq) const {
        const int row0 = u.pm * BM + wr * 64 + fr, col0 = u.pn * BM + wc * 32 + 8 * fq;
#pragma unroll
        for (int ai = 0; ai < 2; ++ai)
#pragma unroll
            for (int m = 0; m < 4; ++m) {
                bf16_t* rowp = O + (size_t)(row0 + ai * HALF + m * 16) * ldc + col0;
#pragma unroll
                for (int bj = 0; bj < 2; ++bj) {
                    f32x4 v0 = acc[ai][bj][m][0], v1 = acc[ai][bj][m][1];
                    if (ACT == 1) {
#pragma unroll
                        for (int j = 0; j < 4; ++j) { v0[j] = gelu_tanh_f(v0[j]); v1[j] = gelu_tanh_f(v1[j]); }
                    }
                    u32x4 w; w.x = cvt_pk_bf16(v0[0], v0[1]); w.y = cvt_pk_bf16(v0[2], v0[3]); w.z = cvt_pk_bf16(v1[0], v1[1]); w.w = cvt_pk_bf16(v1[2], v1[3]);
                    *(u32x4*)(rowp + bj * HALF) = w;
                }
            }
    }
};
template <bool BF16BASE> struct EpiResid {
    static constexpr bool PERM = true, ALIGN = false;
    const void* base0; const void* base1; float* out; float scale;
    DI void operator()(const f32x4 (&acc)[2][2][4][2], const Unit& u, int wr, int wc, int fr, int fq) const {
        const int row0 = u.pm * BM + wr * 64 + fr, col0 = u.pn * BM + wc * 32 + 8 * fq;
#pragma unroll
        for (int ai = 0; ai < 2; ++ai)
#pragma unroll
            for (int m = 0; m < 4; ++m) {
                const int r = row0 + ai * HALF + m * 16;
                float* op = out + (size_t)r * D + col0;
                if (BF16BASE) {
                    const bf16_t* bp = (const bf16_t*)base0 + (size_t)r * D + col0;
#pragma unroll
                    for (int bj = 0; bj < 2; ++bj) { const u32x4 w = *(const u32x4*)(bp + bj * HALF);
                        const f32x4 b0 = {bflo(w.x), bfhi(w.x), bflo(w.y), bfhi(w.y)}, b1 = {bflo(w.z), bfhi(w.z), bflo(w.w), bfhi(w.w)};
                        *(f32x4*)(op + bj * HALF) = b0 * DN_ALPHA + acc[ai][bj][m][0] * scale; *(f32x4*)(op + bj * HALF + 4) = b1 * DN_ALPHA + acc[ai][bj][m][1] * scale; }
                } else {
                    const float* bp = (r < TP ? (const float*)base0 + (size_t)r * D : (const float*)base1 + (size_t)(r - TP) * D) + col0;
#pragma unroll
                    for (int bj = 0; bj < 2; ++bj) { const f32x4 b0 = *(const f32x4*)(bp + bj * HALF), b1 = *(const f32x4*)(bp + bj * HALF + 4);
                        *(f32x4*)(op + bj * HALF) = b0 * DN_ALPHA + acc[ai][bj][m][0] * scale; *(f32x4*)(op + bj * HALF + 4) = b1 * DN_ALPHA + acc[ai][bj][m][1] * scale; }
                }
            }
    }
};

template <int MODE> struct EpiLn {
    static constexpr bool PERM = true, ALIGN = true;
    const void* base0; const void* base1; void* out; float scale; const float* gam; const float* bet; unsigned long long* xs; unsigned tag; LAS unsigned char* lds;
    DI void operator()(f32x4 (&acc)[2][2][4][2], const Unit& u, int wr, int wc, int fr, int fq) const {
        const int row0 = u.pm * BM + wr * 64 + fr, col0 = u.pn * BM + wc * 32 + 8 * fq;
        LAS f32x2* P = (LAS f32x2*)(lds + LDS_LNP); LAS f32x2* Sx = (LAS f32x2*)(lds + LDS_LNS);
        const int tid = (wr * 4 + wc) * 64 + fq * 16 + fr;
#pragma unroll
        for (int ai = 0; ai < 2; ++ai) {
            u32x4 bw[4][2];
            if (MODE != 0) {
#pragma unroll
                for (int m = 0; m < 4; ++m)
#pragma unroll
                    for (int bj = 0; bj < 2; ++bj) bw[m][bj] = *(const u32x4*)((const bf16_t*)base0 + (size_t)(row0 + ai * HALF + m * 16) * D + col0 + bj * HALF);
            }
#pragma unroll
            for (int m = 0; m < 4; ++m) {
                const int r = row0 + ai * HALF + m * 16;
                float s = 0.f, q = 0.f;
#pragma unroll
                for (int bj = 0; bj < 2; ++bj) {
                    f32x4 b0, b1;
                    if (MODE == 0) { const float* bp = (r < TP ? (const float*)base0 + (size_t)r * D : (const float*)base1 + (size_t)(r - TP) * D) + col0 + bj * HALF; b0 = *(const f32x4*)bp; b1 = *(const f32x4*)(bp + 4); }
                    else { const u32x4 w = bw[m][bj];
                        b0 = (f32x4){bflo(w.x), bfhi(w.x), bflo(w.y), bfhi(w.y)}; b1 = (f32x4){bflo(w.z), bfhi(w.z), bflo(w.w), bfhi(w.w)}; }
                    const f32x4 z0 = b0 * DN_ALPHA + acc[ai][bj][m][0] * scale, z1 = b1 * DN_ALPHA + acc[ai][bj][m][1] * scale;
                    acc[ai][bj][m][0] = z0; acc[ai][bj][m][1] = z1;
                    s += ((z0[0] + z0[1]) + (z0[2] + z0[3])) + ((z1[0] + z1[1]) + (z1[2] + z1[3]));
                    q += ((z0[0] * z0[0] + z0[1] * z0[1]) + (z0[2] * z0[2] + z0[3] * z0[3])) + ((z1[0] * z1[0] + z1[1] * z1[1]) + (z1[2] * z1[2] + z1[3] * z1[3]));
                }
                s += __shfl_xor(s, 16); s += __shfl_xor(s, 32); q += __shfl_xor(q, 16); q += __shfl_xor(q, 32);
                if (fq == 0) P[(ai * HALF + wr * 64 + m * 16 + fr) * 4 + wc] = (f32x2){s, q};
                if (MODE == 0 && (m & 1)) asm volatile("" ::: "memory");
            }
            asm volatile("" ::: "memory");
        }
        asm volatile("s_waitcnt lgkmcnt(0)" ::: "memory"); __builtin_amdgcn_s_barrier(); asm volatile("" ::: "memory");
        if (tid < 256) {
            const f32x2 a = P[tid * 4 + 0], b = P[tid * 4 + 1], c = P[tid * 4 + 2], d = P[tid * 4 + 3];
            const float S = (a[0] + b[0]) + (c[0] + d[0]), Q = (a[1] + b[1]) + (c[1] + d[1]);
            unsigned long long* slot = xs + (size_t)u.pm * 4 * BM + tid;
            __hip_atomic_store(slot + u.pn * BM, ((unsigned long long)((__float_as_uint(Q) & ~7u) | tag) << 32) | __float_as_uint(S), __ATOMIC_RELAXED, __HIP_MEMORY_SCOPE_AGENT);
            unsigned long long w[4]; unsigned polls = 0;
            const unsigned long long* s0 = slot; const unsigned long long* s1 = slot + BM; const unsigned long long* s2 = slot + 2 * BM; const unsigned long long* s3 = slot + 3 * BM;
            for (;;) {
                u32x2 l0, l1, l2, l3;
                asm volatile("global_load_dwordx2 %0, %4, off sc1\n\tglobal_load_dwordx2 %1, %5, off sc1\n\tglobal_load_dwordx2 %2, %6, off sc1\n\tglobal_load_dwordx2 %3, %7, off sc1\n\ts_waitcnt vmcnt(0)"
                             : "=&v"(l0), "=&v"(l1), "=&v"(l2), "=&v"(l3) : "v"(s0), "v"(s1), "v"(s2), "v"(s3) : "memory");
                w[0] = ((unsigned long long)l0[1] << 32) | l0[0]; w[1] = ((unsigned long long)l1[1] << 32) | l1[0];
                w[2] = ((unsigned long long)l2[1] << 32) | l2[0]; w[3] = ((unsigned long long)l3[1] << 32) | l3[0];
                const bool ok = ((l0[1] & 7u) == tag) && ((l1[1] & 7u) == tag) && ((l2[1] & 7u) == tag) && ((l3[1] & 7u) == tag);
                if (__builtin_amdgcn_ballot_w64(!ok) == 0ull) break;
                __builtin_amdgcn_s_sleep(24); if (++polls > (1u << 20)) break;
            }
            float S4 = 0.f, Q4 = 0.f;
#pragma unroll
            for (int t = 0; t < 4; ++t) { S4 += __uint_as_float((unsigned)w[t]); Q4 += __uint_as_float((unsigned)(w[t] >> 32) & ~7u); }
            const float mean = S4 * (1.0f / D);
            Sx[tid] = (f32x2){mean, 1.0f / sqrtf(fmaxf(Q4 * (1.0f / D) - mean * mean, 0.f) + LN_EPS)};
        }
        asm volatile("s_waitcnt lgkmcnt(0)" ::: "memory"); __builtin_amdgcn_s_barrier(); asm volatile("" ::: "memory");
        f32x4 gq[2][2], eq[2][2];
#pragma unroll
        for (int bj = 0; bj < 2; ++bj) { const int c = col0 + bj * HALF; gq[bj][0] = *(const f32x4*)(gam + c); gq[bj][1] = *(const f32x4*)(gam + c + 4); eq[bj][0] = *(const f32x4*)(bet + c); eq[bj][1] = *(const f32x4*)(bet + c + 4); }
#pragma unroll
        for (int ai = 0; ai < 2; ++ai)
#pragma unroll
            for (int m = 0; m < 4; ++m) {
                int rl = ai * HALF + wr * 64 + m * 16 + fr; asm volatile("" : "+v"(rl));
                const f32x2 sr = Sx[rl]; const float mean = sr[0], rstd = sr[1];
                const size_t r = (size_t)(u.pm * BM + rl);
#pragma unroll
                for (int bj = 0; bj < 2; ++bj) {
                    const int c = col0 + bj * HALF;
                    const f32x4 g0 = gq[bj][0], g1 = gq[bj][1], e0 = eq[bj][0], e1 = eq[bj][1];
                    const f32x4 y0 = (acc[ai][bj][m][0] - mean) * rstd * g0 + e0, y1 = (acc[ai][bj][m][1] - mean) * rstd * g1 + e1;
                    if (MODE == 2) { float* op = (float*)out + r * D + c; *(f32x4*)op = y0; *(f32x4*)(op + 4) = y1; }
                    else { u32x4 o; o.x = cvt_pk_bf16(y0[0], y0[1]); o.y = cvt_pk_bf16(y0[2], y0[3]); o.z = cvt_pk_bf16(y1[0], y1[1]); o.w = cvt_pk_bf16(y1[2], y1[3]);
                        *(u32x4*)((bf16_t*)out + r * D + c) = o; }
                }
            }
    }
};
struct EpiF1 {
    static constexpr bool PERM = true, ALIGN = false;
    bf16_t* Gt;
    DI void operator()(const f32x4 (&acc)[2][2][4][2], const Unit& u, int wr, int wc, int fr, int fq) const {
        const int row0 = u.pm * BM + wr * 64 + fr, tok0 = u.pn * BM + wc * 32 + 8 * fq;
        const int b = tok0 >> 12, s = tok0 & 4095;
#pragma unroll
        for (int ai = 0; ai < 2; ++ai)
#pragma unroll
            for (int m = 0; m < 4; ++m) {
                const int lp = row0 + ai * HALF + m * 16, ri = lp >> 9, g = (lp >> 7) & 3, l = lp & 127;
                bf16_t* rowp = Gt + (size_t)((b * 4 + g) * 128 + l) * 8192 + ri * 4096 + s;
#pragma unroll
                for (int bj = 0; bj < 2; ++bj) {
                    const f32x4 v0 = acc[ai][bj][m][0], v1 = acc[ai][bj][m][1];
                    u32x4 w; w.x = cvt_pk_bf16(v0[0], v0[1]); w.y = cvt_pk_bf16(v0[2], v0[3]); w.z = cvt_pk_bf16(v1[0], v1[1]); w.w = cvt_pk_bf16(v1[2], v1[3]);
                    *(u32x4*)(rowp + bj * HALF) = w;
                }
            }
    }
};
struct EpiF2 {
    static constexpr bool PERM = true, ALIGN = false;
    bf16_t* MX; float* part;
    DI void operator()(const f32x4 (&acc)[2][2][4][2], const Unit& u, int wr, int wc, int fr, int fq) const {
        const int tid = (wr * 4 + wc) * 64 + fq * 16 + fr;
        f32x4* sp = (f32x4*)part + tid;
        if (u.pm < 8) {
#pragma unroll
            for (int ai = 0; ai < 2; ++ai)
#pragma unroll
                for (int m = 0; m < 4; ++m) {
                    f32x4* sq = sp + (ai * 4 + m) * 4 * 512; asm volatile("" : "+v"(sq));
#pragma unroll
                    for (int bj = 0; bj < 2; ++bj)
#pragma unroll
                        for (int n = 0; n < 2; ++n) sq[(bj * 2 + n) * 512] = acc[ai][bj][m][n];
                }
            return;
        }
        const int row0 = (u.pm - 8) * BM + wr * 64 + fr, cc0 = u.pn * BM + wc * 32 + 8 * fq;
#pragma unroll
        for (int ai = 0; ai < 2; ++ai)
#pragma unroll
            for (int m = 0; m < 4; ++m) {
                int k = row0 + ai * HALF + m * 16; asm volatile("" : "+v"(k));
                const f32x4* sq = sp + (ai * 4 + m) * 4 * 512; asm volatile("" : "+v"(sq));
#pragma unroll
                for (int bj = 0; bj < 2; ++bj) {
                    const int cc = cc0 + bj * HALF, b = cc >> 9, within = cc & 511;
                    const f32x4 c0 = sq[(bj * 2 + 0) * 512], c1 = sq[(bj * 2 + 1) * 512];
                    const f32x4 p0 = (c0 + acc[ai][bj][m][0]) * FSCALE, p1 = (c1 + acc[ai][bj][m][1]) * FSCALE;
                    const f32x4 q0 = (c0 - acc[ai][bj][m][0]) * FSCALE, q1 = (c1 - acc[ai][bj][m][1]) * FSCALE;
                    u32x4 w; w.x = cvt_pk_bf16(p0[0], p0[1]); w.y = cvt_pk_bf16(p0[2], p0[3]); w.z = cvt_pk_bf16(p1[0], p1[1]); w.w = cvt_pk_bf16(p1[2], p1[3]);
                    *(u32x4*)(MX + (size_t)(b * 4096 + k) * 1024 + within) = w;
                    if (k > 0) { u32x4 v; v.x = cvt_pk_bf16(q0[0], q0[1]); v.y = cvt_pk_bf16(q0[2], q0[3]); v.z = cvt_pk_bf16(q1[0], q1[1]); v.w = cvt_pk_bf16(q1[2], q1[3]);
                        *(u32x4*)(MX + (size_t)(b * 4096 + 4096 - k) * 1024 + within) = v; }
                }
                asm volatile("" ::: "memory");
            }
    }
};

template <class Epi, class Sched>
__device__ __forceinline__ void gemm_phase(LAS unsigned char* lds, const Gemm g, const Sched& S, const Epi& E) {
    int tid_ = threadIdx.x; asm volatile("" : "+v"(tid_));
    const int tid = tid_, wid = __builtin_amdgcn_readfirstlane(tid >> 6), lane = tid & 63, wr = wid >> 2, wc = wid & 3, fr = lane & 15, fq = lane >> 4;
    const int K = g.K, nt = K / BK;
    unsigned voffA[2], voffB[2];
#pragma unroll
    for (int i = 0; i < 2; ++i) { int R, C; stage_rc(tid * 16 + i * 8192, R, C); const int Rb = Epi::PERM ? ((R & ~31) + perm32(R & 31)) : R;
        voffA[i] = (unsigned)(R * g.lda + C) * 2u; voffB[i] = (unsigned)(Rb * g.ldb + C) * 2u; }
    const size_t kstep = (size_t)(BK * 2);
    const size_t hstepA = (size_t)HALF * g.lda * 2, hstepB = (size_t)HALF * g.ldb * 2;
    const unsigned ldsw = (unsigned)wid * 1024u;
    const int aoff = lds_byte(wr * 64 + fr, fq * 8), boff = lds_byte(wc * 32 + fr, fq * 8);
#define PG8_SA(b, h) (((b) * 2 + (h)) * HTB)
#define PG8_SB(b, h) ((4 + (b) * 2 + (h)) * HTB)
#define PG8_STAGE(bufoff, gbase, voff) do { _Pragma("unroll") for (int _i = 0; _i < 2; ++_i) \
        __builtin_amdgcn_global_load_lds((const unsigned*)((const char*)(gbase) + (voff)[_i]), (LAS unsigned*)(lds + (bufoff) + ldsw + _i * 8192), 16, 0, 0); } while (0)
#define PG8_LDA(dst, b, h) do { _Pragma("unroll") for (int m = 0; m < 4; ++m) _Pragma("unroll") for (int k = 0; k < 2; ++k) dst[m][k] = *(const LAS bf16x8*)(lds + PG8_SA(b, h) + aoff + m * 2048 + k * 1024); } while (0)
#define PG8_LDB(dst, b, h) do { _Pragma("unroll") for (int n = 0; n < 2; ++n) _Pragma("unroll") for (int k = 0; k < 2; ++k) dst[n][k] = *(const LAS bf16x8*)(lds + PG8_SB(b, h) + boff + n * 2048 + k * 1024); } while (0)
#define PG8_MMA(ai, bj, At, Bt) do { __builtin_amdgcn_s_setprio(1); _Pragma("unroll") for (int m = 0; m < 4; ++m) _Pragma("unroll") for (int n = 0; n < 2; ++n) _Pragma("unroll") for (int k = 0; k < 2; ++k) \
        acc[ai][bj][m][n] = __builtin_amdgcn_mfma_f32_16x16x32_bf16(Bt[n][k], At[m][k], acc[ai][bj][m][n], 0, 0, 0); __builtin_amdgcn_s_setprio(0); } while (0)
#define PG8_WAIT_V(n) asm volatile("s_waitcnt vmcnt(" #n ")" ::: "memory")
#define PG8_WAIT_L(n) asm volatile("s_waitcnt lgkmcnt(" #n ")" ::: "memory")
#define PG8_BAR __builtin_amdgcn_s_barrier()
#define PG8_SCHED __builtin_amdgcn_sched_barrier(0)
    Unit cur, nxt; int ui = 0;
    if (!S.next(0, cur)) return;
    f32x4 acc[2][2][4][2];
#pragma unroll
    for (int a = 0; a < 2; ++a)
#pragma unroll
        for (int b = 0; b < 2; ++b)
#pragma unroll
            for (int m = 0; m < 4; ++m)
#pragma unroll
                for (int n = 0; n < 2; ++n) acc[a][b][m][n] = (f32x4){0.f, 0.f, 0.f, 0.f};
    bf16x8 At[4][2], B0[2][2], B1[2][2];
    const char* cA = (const char*)g.A + (size_t)cur.pm * 2 * hstepA; const char* cB = (const char*)g.Bt + (size_t)cur.pn * 2 * hstepB + S.boff(cur);
    PG8_STAGE(PG8_SB(0, 0), cB, voffB); PG8_STAGE(PG8_SA(0, 0), cA, voffA); PG8_STAGE(PG8_SB(0, 1), cB + hstepB, voffB); PG8_STAGE(PG8_SA(0, 1), cA + hstepA, voffA);
    if (wr == 1) PG8_BAR;
    PG8_WAIT_V(4); PG8_BAR;
    PG8_STAGE(PG8_SB(1, 0), cB + kstep, voffB); PG8_STAGE(PG8_SA(1, 0), cA + kstep, voffA); PG8_STAGE(PG8_SB(1, 1), cB + hstepB + kstep, voffB);
    PG8_WAIT_V(6); PG8_BAR;
    for (;;) {
        const bool has_next = S.next(ui + 1, nxt);
        const char* nA = has_next ? (const char*)g.A + (size_t)nxt.pm * 2 * hstepA : cA; const char* nB = has_next ? (const char*)g.Bt + (size_t)nxt.pn * 2 * hstepB + S.boff(nxt) : cB;
        for (int t = 0; t < nt; t += 2) {
            const bool last = (t == nt - 2);
            const char* a1 = cA + (size_t)(t + 1) * kstep;
            const char* a2 = last ? nA : cA + (size_t)(t + 2) * kstep; const char* b2 = last ? nB : cB + (size_t)(t + 2) * kstep;
            const char* a3 = a2 + kstep; const char* b3 = b2 + kstep;
            PG8_LDB(B0, 0, 0); PG8_SCHED; PG8_LDA(At, 0, 0); PG8_STAGE(PG8_SA(1, 1), a1 + hstepA, voffA);
            PG8_WAIT_L(8); PG8_BAR; PG8_WAIT_L(0); PG8_MMA(0, 0, At, B0); PG8_BAR; PG8_SCHED;
            PG8_LDB(B1, 0, 1); PG8_STAGE(PG8_SB(0, 0), b2, voffB);
            PG8_BAR; PG8_WAIT_L(0); PG8_MMA(0, 1, At, B1); PG8_BAR;
            PG8_LDA(At, 0, 1); PG8_STAGE(PG8_SA(0, 0), a2, voffA);
            PG8_BAR; PG8_WAIT_L(0); PG8_MMA(1, 0, At, B0); PG8_BAR; PG8_SCHED;
            PG8_STAGE(PG8_SB(0, 1), b2 + hstepB, voffB);
            PG8_WAIT_V(6); PG8_BAR; PG8_MMA(1, 1, At, B1); PG8_BAR;
            PG8_LDB(B0, 1, 0); PG8_SCHED; PG8_LDA(At, 1, 0); PG8_STAGE(PG8_SA(0, 1), a2 + hstepA, voffA);
            PG8_WAIT_L(8); PG8_BAR; PG8_WAIT_L(0); PG8_MMA(0, 0, At, B0); PG8_BAR; PG8_SCHED;
            PG8_LDB(B1, 1, 1); PG8_STAGE(PG8_SB(1, 0), b3, voffB);
            PG8_BAR; PG8_WAIT_L(0); PG8_MMA(0, 1, At, B1); PG8_BAR;
            PG8_LDA(At, 1, 1); PG8_STAGE(PG8_SA(1, 0), a3, voffA);
            PG8_BAR; PG8_WAIT_L(0); PG8_MMA(1, 0, At, B0); PG8_BAR; PG8_SCHED;
            PG8_STAGE(PG8_SB(1, 1), b3 + hstepB, voffB);
            PG8_WAIT_V(6); PG8_BAR; PG8_MMA(1, 1, At, B1); PG8_BAR;
        }
        if (Epi::ALIGN) { if (wr == 0) PG8_BAR; }
        E(acc, cur, wr, wc, fr, fq);
        if (Epi::ALIGN) { if (wr == 1) PG8_BAR; }
        if (!has_next) break;
#pragma unroll
        for (int a = 0; a < 2; ++a)
#pragma unroll
            for (int b = 0; b < 2; ++b)
#pragma unroll
                for (int m = 0; m < 4; ++m)
#pragma unroll
                    for (int n = 0; n < 2; ++n) acc[a][b][m][n] = (f32x4){0.f, 0.f, 0.f, 0.f};
        cur = nxt; cA = nA; cB = nB; ++ui;
    }
    PG8_WAIT_V(0);
    if (wr == 0) PG8_BAR;
    PG8_BAR;
#undef PG8_SA
#undef PG8_SB
#undef PG8_STAGE
#undef PG8_LDA
#undef PG8_LDB
#undef PG8_MMA
#undef PG8_WAIT_V
#undef PG8_WAIT_L
#undef PG8_BAR
#undef PG8_SCHED
}
}
using pg8::Gemm; using pg8::StaticOrder;

#define XB_TMO      128
#define XB_XCNT(j)  (256  + 64 * (j))
#define XB_XSUB(j)  (1280 + 64 * (j))
#define XB_XGEN(j)  (2304 + 64 * (j))
#define XB_TOP      3328
#define XB_TOPGEN   3392
#define XCD_BAR_WORDS 3456
#define XB_SPIN_CAP (1u << 20)
DI unsigned xb_ld(unsigned* p)              { return __hip_atomic_load(p, __ATOMIC_RELAXED, __HIP_MEMORY_SCOPE_AGENT); }
DI unsigned xb_add(unsigned* p, unsigned v) { return __hip_atomic_fetch_add(p, v, __ATOMIC_RELAXED, __HIP_MEMORY_SCOPE_AGENT); }
DI unsigned xb_xcc_id() { return (unsigned)__builtin_amdgcn_s_getreg((3 << 11) | 20) & 0xFu; }
#define XB_SPIN(cond, bar) do { unsigned _sp = 0; while (cond) { __builtin_amdgcn_s_sleep(1); \
    if ((++_sp & 255u) == 0u) { if (xb_ld(&(bar)[XB_TMO])) break; if (_sp > XB_SPIN_CAP) { atomicAdd(&(bar)[XB_TMO], 1u); break; } } } } while (0)
DI void xcd_barrier_post(unsigned* bar, volatile LAS unsigned* st) {
    if (threadIdx.x == 0) { const unsigned x = xb_xcc_id(); st[2] = x; (void)xb_add(&bar[XB_XCNT(x)], 1u); }
}
DI void xcd_barrier_complete(unsigned* bar, unsigned x, unsigned& nloc, unsigned& nx) {
    const unsigned G = gridDim.x;
    unsigned sum, cnt, mine, sp = 0u;
    for (;;) {
        sum = 0u; cnt = 0u; mine = 0u;
#pragma unroll
        for (unsigned j = 0; j < 16; ++j) { const unsigned c = xb_ld(&bar[XB_XCNT(j)]); sum += c; cnt += (c > 0u) ? 1u : 0u; mine = (j == x) ? c : mine; }
        if (sum == G) break;
        __builtin_amdgcn_s_sleep(1);
        if ((++sp & 255u) == 0u) { if (xb_ld(&bar[XB_TMO])) break; if (sp > XB_SPIN_CAP) { atomicAdd(&bar[XB_TMO], 1u); break; } }
    }
    nloc = mine > 0u ? mine : 1u; nx = cnt > 0u ? cnt : 1u;
}
DI void xcd_barrier(unsigned* bar, volatile LAS unsigned* st) {
    asm volatile("s_waitcnt vmcnt(0)" ::: "memory");
    __syncthreads();
    if (threadIdx.x == 0) {
        __builtin_amdgcn_s_waitcnt(0);
        unsigned nloc = st[0], nx = st[1]; const unsigned x = st[2];
        if (nloc == 0u) { xcd_barrier_complete(bar, x, nloc, nx); st[0] = nloc; st[1] = nx; }
        const unsigned old = xb_add(&bar[XB_XSUB(x)], 1u);
        const unsigned gen = old / nloc;
        if (old + 1u == (gen + 1u) * nloc) {
            __builtin_amdgcn_fence(__ATOMIC_RELEASE, "agent");
            asm volatile("s_waitcnt vmcnt(0)" ::: "memory");
            const unsigned og = xb_add(&bar[XB_TOP], 1u);
            const unsigned tg = og / nx;
            if (og + 1u == (tg + 1u) * nx) xb_add(&bar[XB_TOPGEN], 1u);
            else XB_SPIN(xb_ld(&bar[XB_TOPGEN]) == tg, bar);
            __builtin_amdgcn_fence(__ATOMIC_ACQUIRE, "agent");
            xb_add(&bar[XB_XGEN(x)], 1u);
            asm volatile("s_waitcnt vmcnt(0)" ::: "memory");
        } else {
            XB_SPIN(xb_ld(&bar[XB_XGEN(x)]) == gen, bar);
            __builtin_amdgcn_fence(__ATOMIC_ACQUIRE, "agent");
            asm volatile("s_waitcnt vmcnt(0)" ::: "memory");
        }
    }
    __syncthreads();
}

struct Params { const float* in[18]; float* out; unsigned char* ws; int ph_lo, ph_hi; };
struct Ctx {
    LAS unsigned long long* tab;
    DI unsigned long long raw(int i) const { const unsigned long long v = tab[i]; const unsigned lo = __builtin_amdgcn_readfirstlane((unsigned)v), hi = __builtin_amdgcn_readfirstlane((unsigned)(v >> 32)); return ((unsigned long long)hi << 32) | lo; }
    DI const float* in(int i) const { return (const float*)raw(i); }
    DI float* out() const { return (float*)raw(18); }
    DI unsigned char* wsp() const { return (unsigned char*)raw(19); }
};
enum { I_XP = 0, I_XS, I_WG, I_WU, I_WDN, I_LNG, I_LNB, I_ABI, I_ABO, I_DF, I_DB, I_CW, I_CDI, I_CDO, I_SLG, I_SLB, I_SW, I_SB };

#define MFMA16(a, b, c) __builtin_amdgcn_mfma_f32_16x16x32_bf16((a), (b), (c), 0, 0, 0)

DI void transpose_item(const float* src, int ld, bf16_t* dst, int K, int k0, int nsrc0, int drow0, LAS float* scr, int lane) {
    f32x2 v[16];
#pragma unroll
    for (int i = 0; i < 16; ++i) { const int kk = (lane >> 4) + 4 * i; v[i] = __builtin_nontemporal_load((const f32x2*)(src + (size_t)(k0 + kk) * ld + nsrc0 + (lane & 15) * 2)); }
#pragma unroll
    for (int i = 0; i < 16; ++i) { const int kk = (lane >> 4) + 4 * i; scr[kk * 33 + (lane & 15) * 2] = v[i][0]; scr[kk * 33 + (lane & 15) * 2 + 1] = v[i][1]; }
    LDS_WAIT();
    const int c = lane & 7;
#pragma unroll
    for (int j = 0; j < 4; ++j) { const int n = (lane >> 3) + 8 * j; const LAS float* s = scr + (8 * c) * 33 + n;
        u32x4 o; o.x = pk2(s[0 * 33], s[1 * 33]); o.y = pk2(s[2 * 33], s[3 * 33]); o.z = pk2(s[4 * 33], s[5 * 33]); o.w = pk2(s[6 * 33], s[7 * 33]);
        *(u32x4*)(dst + (size_t)(drow0 + n) * K + k0 + 8 * c) = o; }
    LDS_WAIT();
}
DI void phase_prep(const Ctx& p, LAS unsigned char* lds) {
    int tid_ = threadIdx.x; asm volatile("" : "+v"(tid_));
    const int tid = tid_, lane = tid & 63, wave = tid >> 6, G = gridDim.x;
    unsigned char* ws = p.wsp();
    LAS float* ctab = (LAS float*)(lds + 8 * 8448);
    for (int m = tid; m < 4096; m += 512) ctab[m] = cospif((float)m * (1.0f / 2048.0f));
    __syncthreads();
    {
        LAS float* scr = (LAS float*)(lds + wave * 8448);
        const int gw = blockIdx.x * 8 + wave, NGW = G * 8;
        constexpr int NI_FFN = 4 * 4224, NI_ABI = 1792, NI_SQ = 512;
        constexpr int NITEMS = NI_FFN + NI_ABI + 3 * NI_SQ;
        for (int it = gw; it < NITEMS; it += NGW) {
            int r = it;
            if (r < NI_FFN) {
                const int idx = r / 4224, r2 = r % 4224, which = r2 / 1408, item = r2 % 1408;
                if (which < 2) { const float* src = (which ? p.in(I_WU) : p.in(I_WG)) + (size_t)idx * 1024 * FF; const int kb = item / 88, nb = item % 88, n0 = nb * 32;
                    transpose_item(src, FF, (bf16_t*)(ws + WS_WGU + idx * SZ_WGU), 1024, kb * 64, n0, (n0 >> 7) * 256 + which * 128 + (n0 & 127), scr, lane); }
                else { const float* src = p.in(I_WDN) + (size_t)idx * FF * 1024; const int kb = item / 32, nb = item % 32;
                    transpose_item(src, 1024, (bf16_t*)(ws + WS_WD + idx * SZ_WD), FF, kb * 64, nb * 32, nb * 32, scr, lane); }
                continue;
            }
            r -= NI_FFN;
            if (r < NI_ABI) { const int kb = r / 112, nb = r % 112; transpose_item(p.in(I_ABI), ABN, (bf16_t*)(ws + WS_WABI), 1024, kb * 64, nb * 32, nb * 32, scr, lane); continue; }
            r -= NI_ABI;
            const int kb = (r % NI_SQ) / 32, nb = r % 32;
            if (r < NI_SQ) transpose_item(p.in(I_ABO), 1024, (bf16_t*)(ws + WS_WABO), 1024, kb * 64, nb * 32, nb * 32, scr, lane);
            else if (r < 2 * NI_SQ) transpose_item(p.in(I_CDI), 1536, (bf16_t*)(ws + WS_WUV), 1024, kb * 64, 512 + nb * 32, nb * 32, scr, lane);
            else transpose_item(p.in(I_CDO), 1024, (bf16_t*)(ws + WS_WCDO), 1024, kb * 64, nb * 32, nb * 32, scr, lane);
        }
    }
    const size_t gtid = (size_t)blockIdx.x * 512 + tid, NT = (size_t)G * 512;
    {
        bf16_t* xb = (bf16_t*)(ws + WS_XB);
        constexpr size_t NV = (size_t)T * D / 8;
        for (size_t e0 = gtid; e0 < NV; e0 += 4 * NT) {
            f32x4 a[4], b[4];
#pragma unroll
            for (int q = 0; q < 4; ++q) { const size_t e = e0 + q * NT; if (e < NV) { const size_t el = e * 8; const float* src = el < (size_t)TP * D ? p.in(I_XP) + el : p.in(I_XS) + (el - (size_t)TP * D);
                a[q] = __builtin_nontemporal_load((const f32x4*)src); b[q] = __builtin_nontemporal_load((const f32x4*)(src + 4)); } }
#pragma unroll
            for (int q = 0; q < 4; ++q) { const size_t e = e0 + q * NT; if (e < NV) { u32x4 o; o.x = pk2(a[q][0], a[q][1]); o.y = pk2(a[q][2], a[q][3]); o.z = pk2(b[q][0], b[q][1]); o.w = pk2(b[q][2], b[q][3]);
                *(u32x4*)(xb + e * 8) = o; } }
        }
    }
    {
        bf16_t* dft = (bf16_t*)(ws + WS_DFT);
        for (size_t e = gtid; e < (size_t)4096 * 512; e += NT) {
            const int r = (int)(e >> 9), s0 = (int)(e & 511) * 8, k = r & 2047; float v[8];
#pragma unroll
            for (int j = 0; j < 8; ++j) { const int m = (k * (s0 + j)) & 4095; v[j] = ctab[r < 2048 ? m : ((m - 1024) & 4095)]; }
            u32x4 o; o.x = pk2(v[0], v[1]); o.y = pk2(v[2], v[3]); o.z = pk2(v[4], v[5]); o.w = pk2(v[6], v[7]);
            *(u32x4*)(dft + (size_t)r * 4096 + s0) = o;
        }
    }
    {
        float* rc = (float*)(ws + WS_ROPE); float* rs = rc + 4096 * 64;
        for (size_t e = gtid; e < (size_t)4096 * 64; e += NT) {
            const int pos = (int)(e >> 6), i = (int)(e & 63);
            const float invf = exp2f(-(float)i * 0.2076205059304601f);
            const float ang = (float)pos * invf;
            const float nn = rintf(ang * 0.15915494309189535f);
            float r = fmaf(-nn, 6.2831854820251465f, ang); r = fmaf(-nn, -1.7484555e-7f, r);
            const float a = r * 0.3183098861837907f;
            rc[e] = cospif(a); rs[e] = sinpif(a);
        }
    }
    __syncthreads();
    {
        bf16_t* wf1 = (bf16_t*)(ws + WS_WF1); const float* W = p.in(I_CDI);
        LAS float* Wl = (LAS float*)lds;
        LAS f32x2* tw2 = (LAS f32x2*)(lds + 8320);
        if (tid < 128) tw2[tid] = (f32x2){ctab[tid * 32], ctab[(tid * 32 - 1024) & 4095]};
        for (int item = blockIdx.x; item < 256; item += G) {
            const int g = item & 3, d0 = (item >> 2) * 16;
            { const int dd = tid >> 5, c4 = tid & 31; const f32x4 w = *(const f32x4*)(W + (size_t)(d0 + dd) * 1536 + g * 128 + 4 * c4);
              Wl[dd * 129 + 4 * c4] = w[0]; Wl[dd * 129 + 4 * c4 + 1] = w[1]; Wl[dd * 129 + 4 * c4 + 2] = w[2]; Wl[dd * 129 + 4 * c4 + 3] = w[3]; }
            __syncthreads();
            const int dd = tid & 15, lb = tid >> 4;
            for (int k = 0; k < 3; ++k) {
                if (k == 2 && lb != 0) break;
                const int l = k == 2 ? 64 : lb + 32 * k; float ac = 0.f, as = 0.f; int m = 0;
#pragma unroll 8
                for (int c = 0; c < 128; ++c) { const f32x2 t = tw2[m]; const float w = Wl[dd * 129 + c]; ac += w * t[0]; as += w * t[1]; m = (m + l) & 127; }
                bf16_t* o = wf1 + (size_t)(g * 128) * 1024 + d0 + dd;
                o[(size_t)l * 1024] = f2bf(ac); o[(size_t)(512 + l) * 1024] = f2bf(-as);
                if (l > 0 && l < 64) { o[(size_t)(128 - l) * 1024] = f2bf(ac); o[(size_t)(512 + 128 - l) * 1024] = f2bf(as); }
            }
            __syncthreads();
        }
    }
    {
        bf16_t* sw = (bf16_t*)(ws + WS_SGUW);
        for (size_t e = gtid; e < (size_t)65536; e += NT) sw[e] = f2bf(p.in(I_SW)[e]);
    }
}

DI void phase_ln(float* x, bf16_t* xb, const float* g, const float* b, bool final_f32, int nrows = T) {
    int tid_ = threadIdx.x; asm volatile("" : "+v"(tid_));
    const int tid = tid_, lane = tid & 63, wave = tid >> 6;
    f32x4 g4[4], b4[4];
#pragma unroll
    for (int j = 0; j < 4; ++j) { g4[j] = ((const f32x4*)g)[lane + 64 * j]; b4[j] = ((const f32x4*)b)[lane + 64 * j]; }
    const int NW = gridDim.x * 8;
    for (int row0 = blockIdx.x * 8 + wave; row0 < nrows; row0 += 2 * NW) {
        const int row1 = row0 + NW; const bool has1 = row1 < nrows;
        f32x4* xr0 = (f32x4*)(x + (size_t)row0 * D) + lane; f32x4* xr1 = (f32x4*)(x + (size_t)(has1 ? row1 : row0) * D) + lane;
        f32x4 v[4], w[4]; float s = 0.f, s1 = 0.f;
#pragma unroll
        for (int j = 0; j < 4; ++j) { v[j] = xr0[64 * j]; w[j] = xr1[64 * j]; }
#pragma unroll
        for (int j = 0; j < 4; ++j) { s += (v[j][0] + v[j][1]) + (v[j][2] + v[j][3]); s1 += (w[j][0] + w[j][1]) + (w[j][2] + w[j][3]); }
#pragma unroll
        for (int o = 1; o < 64; o <<= 1) { s += __shfl_xor(s, o); s1 += __shfl_xor(s1, o); }
        const float mean = s * (1.0f / D), mean1 = s1 * (1.0f / D); float q = 0.f, q1 = 0.f;
#pragma unroll
        for (int j = 0; j < 4; ++j) { v[j] = v[j] - mean; q += (v[j][0] * v[j][0] + v[j][1] * v[j][1]) + (v[j][2] * v[j][2] + v[j][3] * v[j][3]);
            w[j] = w[j] - mean1; q1 += (w[j][0] * w[j][0] + w[j][1] * w[j][1]) + (w[j][2] * w[j][2] + w[j][3] * w[j][3]); }
#pragma unroll
        for (int o = 1; o < 64; o <<= 1) { q += __shfl_xor(q, o); q1 += __shfl_xor(q1, o); }
        const float rstd = 1.0f / sqrtf(q * (1.0f / D) + LN_EPS), rstd1 = 1.0f / sqrtf(q1 * (1.0f / D) + LN_EPS);
        u32x2* o8 = (u32x2*)(xb + (size_t)row0 * D) + lane; u32x2* o81 = (u32x2*)(xb + (size_t)row1 * D) + lane;
#pragma unroll
        for (int j = 0; j < 4; ++j) { const f32x4 y = v[j] * rstd * g4[j] + b4[j];
            if (final_f32) xr0[64 * j] = y; else { u32x2 t; t.x = pk2(y[0], y[1]); t.y = pk2(y[2], y[3]); o8[64 * j] = t; } }
        if (has1) {
#pragma unroll
            for (int j = 0; j < 4; ++j) { const f32x4 y = w[j] * rstd1 * g4[j] + b4[j];
                if (final_f32) xr1[64 * j] = y; else { u32x2 t; t.x = pk2(y[0], y[1]); t.y = pk2(y[2], y[3]); o81[64 * j] = t; } }
        }
    }
}

DI float log_sigmoid_f(float x) { return -log1pf(expf(-x)); }
constexpr int LP = 136;

template <bool TRANSPOSED>
DI void load_k_rot(const bf16_t* pj, int h, int n, const float* rc, const float* rs, LAS bf16_t* dst, int tid) {
#pragma unroll
    for (int it = 0; it < 2; ++it) {
        const int idx = tid + 512 * it; const int j = TRANSPOSED ? (idx & 127) : (idx >> 3), c8 = TRANSPOSED ? (idx >> 7) : (idx & 7);
        const bf16_t* kp = pj + (size_t)j * ABN + 512 + h * 128 + 8 * c8;
        const u32x4 k1 = *(const u32x4*)kp, k2 = *(const u32x4*)(kp + 64);
        const int pos = n * 128 + j; const float* cp = rc + pos * 64 + 8 * c8; const float* sp = rs + pos * 64 + 8 * c8;
        const f32x4 ca = *(const f32x4*)cp, cb = *(const f32x4*)(cp + 4), sa = *(const f32x4*)sp, sb = *(const f32x4*)(sp + 4);
        float o1[8], o2[8];
#pragma unroll
        for (int e = 0; e < 8; ++e) {
            const unsigned w1 = k1[e >> 1], w2 = k2[e >> 1]; const float t1 = (e & 1) ? bfhi(w1) : bflo(w1), t2 = (e & 1) ? bfhi(w2) : bflo(w2);
            const float c = e < 4 ? ca[e & 3] : cb[e & 3], s = e < 4 ? sa[e & 3] : sb[e & 3];
            o1[e] = (t1 * c - t2 * s) * KSCALE; o2[e] = (t2 * c + t1 * s) * KSCALE;
        }
        if (TRANSPOSED) {
#pragma unroll
            for (int e = 0; e < 8; ++e) { dst[(8 * c8 + e) * LP + j] = f2bf(o1[e]); dst[(64 + 8 * c8 + e) * LP + j] = f2bf(o2[e]); }
        } else {
            u32x4 a, b; a.x = pk2(o1[0], o1[1]); a.y = pk2(o1[2], o1[3]); a.z = pk2(o1[4], o1[5]); a.w = pk2(o1[6], o1[7]);
            b.x = pk2(o2[0], o2[1]); b.y = pk2(o2[2], o2[3]); b.z = pk2(o2[4], o2[5]); b.w = pk2(o2[6], o2[7]);
            *(LAS u32x4*)(dst + j * LP + 8 * c8) = a; *(LAS u32x4*)(dst + j * LP + 64 + 8 * c8) = b;
        }
    }
}
DI void load_tile_T(const bf16_t* src, int ld, LAS bf16_t* VT, int tid) {
#pragma unroll
    for (int it = 0; it < 4; ++it) {
        const int idx = tid + 512 * it, j = idx & 127, c = idx >> 7;
        const u32x4 v = *(const u32x4*)(src + (size_t)j * ld + 8 * c);
#pragma unroll
        for (int e = 0; e < 8; ++e) { const unsigned w = v[e >> 1]; VT[(8 * c + e) * LP + j] = (bf16_t)((e & 1) ? (w >> 16) : (w & 0xffffu)); }
    }
}

DI void tr_read8(unsigned addr, u32x2 (&r)[8]) {
    asm volatile("ds_read_b64_tr_b16 %0, %8\n\tds_read_b64_tr_b16 %1, %8 offset:1088\n\tds_read_b64_tr_b16 %2, %8 offset:8704\n\tds_read_b64_tr_b16 %3, %8 offset:9792\n\t"
                 "ds_read_b64_tr_b16 %4, %8 offset:17408\n\tds_read_b64_tr_b16 %5, %8 offset:18496\n\tds_read_b64_tr_b16 %6, %8 offset:26112\n\tds_read_b64_tr_b16 %7, %8 offset:27200\n\ts_waitcnt lgkmcnt(0)"
                 : "=&v"(r[0]), "=&v"(r[1]), "=&v"(r[2]), "=&v"(r[3]), "=&v"(r[4]), "=&v"(r[5]), "=&v"(r[6]), "=&v"(r[7]) : "v"(addr) : "memory");
}
DI void tr_read8b(unsigned addr, u32x2 (&r)[8]) {
    asm volatile("ds_read_b64_tr_b16 %0, %8\n\tds_read_b64_tr_b16 %1, %8 offset:4352\n\tds_read_b64_tr_b16 %2, %8 offset:8704\n\tds_read_b64_tr_b16 %3, %8 offset:13056\n\t"
                 "ds_read_b64_tr_b16 %4, %8 offset:17408\n\tds_read_b64_tr_b16 %5, %8 offset:21760\n\tds_read_b64_tr_b16 %6, %8 offset:26112\n\tds_read_b64_tr_b16 %7, %8 offset:30464\n\ts_waitcnt lgkmcnt(0)"
                 : "=&v"(r[0]), "=&v"(r[1]), "=&v"(r[2]), "=&v"(r[3]), "=&v"(r[4]), "=&v"(r[5]), "=&v"(r[6]), "=&v"(r[7]) : "v"(addr) : "memory");
}
static_assert(LP * 2 * 16 == 4352, "tr_read8b offsets assume the 136-element pitch");
static_assert(LP * 2 * 4 == 1088 && LP * 2 * 32 == 8704, "tr_read8 offsets assume the 136-element pitch");
DI void load_tile_rm(const bf16_t* src, int ld, LAS bf16_t* Vs, int tid) {
#pragma unroll
    for (int it = 0; it < 4; ++it) { const int idx = tid + 512 * it, j = idx >> 4, c = idx & 15; *(LAS u32x4*)(Vs + j * LP + 8 * c) = *(const u32x4*)(src + (size_t)j * ld + 8 * c); }
}

DI void phase_r1(const Ctx& p, LAS unsigned char* lds, int sl) {
    int tid_ = threadIdx.x; asm volatile("" : "+v"(tid_));
    const int tid = tid_, lane = tid & 63, wave = tid >> 6, l15 = lane & 15, quad = lane >> 4;
    unsigned char* ws = p.wsp();
    const bf16_t* PJ = (const bf16_t*)(ws + WS_S + S_PJ); float* KV = (float*)(ws + WS_S + S_KV);
    const float* rc = (const float*)(ws + WS_ROPE); const float* rs = rc + 4096 * 64;
    LAS bf16_t* KT = (LAS bf16_t*)lds; LAS bf16_t* VT = KT + 128 * LP;
    for (int u = blockIdx.x; u < 512; u += gridDim.x) {
        const int bl = u >> 7, n = (u >> 2) & 31, h = u & 3;
        const bf16_t* pj = PJ + (size_t)(bl * 4096 + n * 128) * ABN;
        load_k_rot<false>(pj, h, n, rc, rs, KT, tid);
        load_tile_rm(pj + 1024 + h * 128, ABN, VT, tid);
        __syncthreads();
        const float l2f = log_sigmoid_f(p.in(I_DF)[h]) * 1.4426950408889634f, l2b = log_sigmoid_f(p.in(I_DB)[h]) * 1.4426950408889634f;
        const unsigned trl = (unsigned)(((8 * quad + (l15 >> 2)) * LP + 4 * (l15 & 3)) * 2);
        bf16x8 Af[4], Ab[4];
        const float rF = exp2f(-l2f), rB = exp2f(l2b);
        {
            u32x2 vr[8]; tr_read8((unsigned)(128 * LP * 2) + trl + (unsigned)(16 * wave * 2), vr);
#pragma unroll
            for (int js = 0; js < 4; ++js) {
                const u32x4 raw = {vr[2 * js][0], vr[2 * js][1], vr[2 * js + 1][0], vr[2 * js + 1][1]};
                const int j0 = 32 * js + quad * 8;
                float kf = exp2f(l2f * (float)(127 - j0)), kb = exp2f(l2b * (float)j0);
                u32x4 pf, pb;
#pragma unroll
                for (int e2 = 0; e2 < 4; ++e2) { const float f0 = bflo(raw[e2]), f1 = bfhi(raw[e2]);
                    const float kf1 = kf * rF, kb1 = kb * rB;
                    pf[e2] = pk2(f0 * kf, f1 * kf1); pb[e2] = pk2(f0 * kb, f1 * kb1);
                    kf = kf1 * rF; kb = kb1 * rB; }
                Af[js] = __builtin_bit_cast(bf16x8, pf); Ab[js] = __builtin_bit_cast(bf16x8, pb);
            }
        }
        f32x4 accf[8], accb[8];
#pragma unroll
        for (int dt = 0; dt < 8; ++dt) { accf[dt] = (f32x4){0.f, 0.f, 0.f, 0.f}; accb[dt] = (f32x4){0.f, 0.f, 0.f, 0.f}; }
#pragma unroll
        for (int dt = 0; dt < 8; ++dt) {
            u32x2 kr[8]; tr_read8(trl + (unsigned)(16 * dt * 2), kr);
#pragma unroll
            for (int js = 0; js < 4; ++js) {
                const u32x4 kw = {kr[2 * js][0], kr[2 * js][1], kr[2 * js + 1][0], kr[2 * js + 1][1]};
                const bf16x8 kb = __builtin_bit_cast(bf16x8, kw);
                accf[dt] = MFMA16(kb, Af[js], accf[dt]); accb[dt] = MFMA16(kb, Ab[js], accb[dt]);
            }
        }
        float* kvf = KV + (size_t)(u * 2) * 16384 + (16 * wave + l15) * 128 + quad * 4; float* kvb = kvf + 16384;
#pragma unroll
        for (int dt = 0; dt < 8; ++dt) { *(f32x4*)(kvf + 16 * dt) = accf[dt]; *(f32x4*)(kvb + 16 * dt) = accb[dt]; }
        __syncthreads();
    }
    {
        bf16_t* MX = (bf16_t*)p.out(); const float* cw = p.in(I_CW);
        const size_t gtid = (size_t)blockIdx.x * 512 + tid, NT = (size_t)gridDim.x * 512;
        for (size_t e0 = gtid; e0 < (size_t)SLAB * 64; e0 += 2 * NT) {
            u32x4 gb[2], gc[2], hc[2], gcl[2], hcl[2], gcr[2], hcr[2]; int tt[2], chh[2]; bool ok[2];
#pragma unroll
            for (int q = 0; q < 2; ++q) {
                const size_t e = e0 + q * NT; ok[q] = e < (size_t)SLAB * 64; const size_t ee = ok[q] ? e : e0;
                const int t = (int)(ee >> 6), ch = (int)(ee & 63) * 8, pos = t & 4095; tt[q] = t; chh[q] = ch;
                const bf16_t* r0 = PJ + (size_t)t * ABN;
                gb[q] = *(const u32x4*)(r0 + 2048 + ch); gc[q] = *(const u32x4*)(r0 + 2560 + ch); hc[q] = *(const u32x4*)(r0 + 3072 + ch);
                gcl[q] = (u32x4){0u, 0u, 0u, 0u}; hcl[q] = gcl[q]; gcr[q] = gcl[q]; hcr[q] = gcl[q];
                if (pos > 0) { gcl[q] = *(const u32x4*)(r0 - ABN + 2560 + ch); hcl[q] = *(const u32x4*)(r0 - ABN + 3072 + ch); }
                if (pos < 4095) { gcr[q] = *(const u32x4*)(r0 + ABN + 2560 + ch); hcr[q] = *(const u32x4*)(r0 + ABN + 3072 + ch); }
            }
#pragma unroll
            for (int q = 0; q < 2; ++q) {
                if (!ok[q]) continue;
                const int ch = chh[q]; float o[8];
#pragma unroll
                for (int jj = 0; jj < 8; ++jj) {
                    const int qq = jj >> 1; const bool hi = jj & 1;
                    const float zl = (hi ? bfhi(gcl[q][qq]) : bflo(gcl[q][qq])) * (hi ? bfhi(hcl[q][qq]) : bflo(hcl[q][qq]));
                    const float z0 = (hi ? bfhi(gc[q][qq]) : bflo(gc[q][qq])) * (hi ? bfhi(hc[q][qq]) : bflo(hc[q][qq]));
                    const float zr = (hi ? bfhi(gcr[q][qq]) : bflo(gcr[q][qq])) * (hi ? bfhi(hcr[q][qq]) : bflo(hcr[q][qq]));
                    const float cv = cw[ch + jj] * zl + cw[512 + ch + jj] * z0 + cw[1024 + ch + jj] * zr;
                    o[jj] = (hi ? bfhi(gb[q][qq]) : bflo(gb[q][qq])) * cv;
                }
                u32x4 w; w.x = pk2(o[0], o[1]); w.y = pk2(o[2], o[3]); w.z = pk2(o[4], o[5]); w.w = pk2(o[6], o[7]);
                *(u32x4*)(MX + (size_t)(sl * SLAB + tt[q]) * D + 512 + ch) = w;
            }
        }
    }
}

DI void phase_r2(const Ctx& p) {
    unsigned char* ws = p.wsp();
    const float* KV = (const float*)(ws + WS_S + S_KV); bf16_t* ST = (bf16_t*)(ws + WS_S + S_ST);
    int tid_ = threadIdx.x; asm volatile("" : "+v"(tid_));
    const size_t gtid = (size_t)blockIdx.x * 512 + tid_, NT = (size_t)gridDim.x * 512;
    for (size_t e = gtid; e < 131072; e += NT) {
        const int dir = (int)(e >> 16), bh = (int)(e >> 12) & 15, bl = bh >> 2, h = bh & 3, q4 = (int)(e & 4095);
        const float lg = log_sigmoid_f(dir ? p.in(I_DB)[h] : p.in(I_DF)[h]); const float cd = expf(128.0f * lg);
        f32x4 st = {0.f, 0.f, 0.f, 0.f};
        for (int s8 = 0; s8 < 32; s8 += 8) {
            f32x4 kv[8]; size_t off[8];
#pragma unroll
            for (int j = 0; j < 8; ++j) { const int step = s8 + j, n = dir ? 31 - step : step; const int u = (bl * 32 + n) * 4 + h; off[j] = (size_t)(u * 2 + dir) * 16384 + q4 * 4; kv[j] = *(const f32x4*)(KV + off[j]); }
#pragma unroll
            for (int j = 0; j < 8; ++j) { u32x2 w; w.x = pk2(st[0], st[1]); w.y = pk2(st[2], st[3]); *(u32x2*)(ST + off[j]) = w; st = st * cd + kv[j]; }
        }
    }
}

DI void phase_r3(const Ctx& p, LAS unsigned char* lds, int sl) {
    int tid_ = threadIdx.x; asm volatile("" : "+v"(tid_));
    const int tid = tid_, lane = tid & 63, wave = tid >> 6, l15 = lane & 15, quad = lane >> 4;
    unsigned char* ws = p.wsp();
    const bf16_t* PJ = (const bf16_t*)(ws + WS_S + S_PJ); const bf16_t* ST = (const bf16_t*)(ws + WS_S + S_ST);
    bf16_t* MX = (bf16_t*)p.out();
    const float* rc = (const float*)(ws + WS_ROPE); const float* rs = rc + 4096 * 64;
    LAS bf16_t* Ks = (LAS bf16_t*)lds; LAS bf16_t* VT = Ks + 128 * LP; LAS bf16_t* SFl = VT + 128 * LP; LAS bf16_t* SBl = SFl + 128 * LP;
    LAS float* DT = (LAS float*)(lds + LDS_LNS);
    for (int u = blockIdx.x; u < 512; u += gridDim.x) {
        const int bl = u >> 7, n = (u >> 2) & 31, h = u & 3;
        const int rowbase = bl * 4096 + n * 128;
        const bf16_t* pj = PJ + (size_t)rowbase * ABN;
        const bf16_t* stf = ST + (size_t)(u * 2) * 16384; const bf16_t* stb = stf + 16384;
        {
            u32x4 sv[8];
#pragma unroll
            for (int it = 0; it < 4; ++it) { const int idx = tid + 512 * it; sv[it] = *(const u32x4*)(stf + (idx >> 4) * 128 + (idx & 15) * 8); sv[4 + it] = *(const u32x4*)(stb + (idx >> 4) * 128 + (idx & 15) * 8); }
            load_k_rot<false>(pj, h, n, rc, rs, Ks, tid);
            load_tile_rm(pj + 1024 + h * 128, ABN, VT, tid);
#pragma unroll
            for (int it = 0; it < 4; ++it) { const int idx = tid + 512 * it; *(LAS u32x4*)(SFl + (idx >> 4) * LP + (idx & 15) * 8) = sv[it]; *(LAS u32x4*)(SBl + (idx >> 4) * LP + (idx & 15) * 8) = sv[4 + it]; }
        }
        const float l2f = log_sigmoid_f(p.in(I_DF)[h]) * 1.4426950408889634f, l2b = log_sigmoid_f(p.in(I_DB)[h]) * 1.4426950408889634f;
        if (tid < 256) DT[tid] = exp2f((tid < 128 ? l2f : l2b) * (float)(tid & 127));
        const int ii = 16 * wave + l15;
        bf16x8 Qa[4];
        {
            const bf16_t* qrow = pj + (size_t)ii * ABN + h * 128; const int pos = n * 128 + ii;
#pragma unroll
            for (int ks = 0; ks < 2; ++ks) {
                const int d0 = 32 * ks + quad * 8;
                const u32x4 q1 = *(const u32x4*)(qrow + d0), q2 = *(const u32x4*)(qrow + 64 + d0);
                const float* cp = rc + pos * 64 + d0; const float* sp = rs + pos * 64 + d0;
                const f32x4 ca = *(const f32x4*)cp, cb = *(const f32x4*)(cp + 4), sa = *(const f32x4*)sp, sb = *(const f32x4*)(sp + 4);
                u32x4 p1, p2;
#pragma unroll
                for (int e2 = 0; e2 < 4; ++e2) {
                    const float a1 = bflo(q1[e2]), b1 = bfhi(q1[e2]), a2 = bflo(q2[e2]), b2 = bfhi(q2[e2]);
                    const float c0 = e2 < 2 ? ca[2 * e2] : cb[2 * e2 - 4], c1 = e2 < 2 ? ca[2 * e2 + 1] : cb[2 * e2 - 3], s0 = e2 < 2 ? sa[2 * e2] : sb[2 * e2 - 4], s1 = e2 < 2 ? sa[2 * e2 + 1] : sb[2 * e2 - 3];
                    p1[e2] = pk2(a1 * c0 - a2 * s0, b1 * c1 - b2 * s1); p2[e2] = pk2(a2 * c0 + a1 * s0, b2 * c1 + b1 * s1);
                }
                Qa[ks] = __builtin_bit_cast(bf16x8, p1); Qa[ks + 2] = __builtin_bit_cast(bf16x8, p2);
            }
        }
        __syncthreads();
        bf16x8 Pb[4];
#pragma unroll
        for (int t = 0; t < 4; ++t) {
            f32x4 s0 = {0.f, 0.f, 0.f, 0.f}, s1 = {0.f, 0.f, 0.f, 0.f};
#pragma unroll
            for (int ks = 0; ks < 4; ++ks) {
                const bf16x8 k0 = *(const LAS bf16x8*)(Ks + (32 * t + l15) * LP + 32 * ks + quad * 8);
                const bf16x8 k1 = *(const LAS bf16x8*)(Ks + (32 * t + 16 + l15) * LP + 32 * ks + quad * 8);
                s0 = MFMA16(k0, Qa[ks], s0); s1 = MFMA16(k1, Qa[ks], s1);
            }
            float pm0[4], pm1[4];
#pragma unroll
            for (int r = 0; r < 4; ++r) {
                const int j0 = 32 * t + quad * 4 + r, j1 = j0 + 16; const int d0 = ii - j0, d1 = ii - j1;
                const float m0 = DT[d0 >= 0 ? d0 : 128 - d0], m1 = DT[d1 >= 0 ? d1 : 128 - d1];
                pm0[r] = s0[r] * m0; pm1[r] = s1[r] * m1;
            }
            { u32x4 pp; pp[0] = pk2(pm0[0], pm0[1]); pp[1] = pk2(pm0[2], pm0[3]); pp[2] = pk2(pm1[0], pm1[1]); pp[3] = pk2(pm1[2], pm1[3]); Pb[t] = __builtin_bit_cast(bf16x8, pp); }
        }
        const float rf = exp2f(l2f * (float)(ii + 1)), rb = exp2f(l2b * (float)(128 - ii));
        f32x4 O[8];
#pragma unroll
        for (int vt = 0; vt < 8; ++vt) {
            f32x4 aF = {0.f, 0.f, 0.f, 0.f}, aB = {0.f, 0.f, 0.f, 0.f};
#pragma unroll
            for (int ks = 0; ks < 4; ++ks) {
                const bf16x8 sf = *(const LAS bf16x8*)(SFl + (16 * vt + l15) * LP + 32 * ks + quad * 8);
                const bf16x8 sb = *(const LAS bf16x8*)(SBl + (16 * vt + l15) * LP + 32 * ks + quad * 8);
                aF = MFMA16(sf, Qa[ks], aF); aB = MFMA16(sb, Qa[ks], aB);
            }
            f32x4 o = aF * rf + aB * rb;
            {
                u32x2 vr[8]; tr_read8b((unsigned)(128 * LP * 2) + (unsigned)(((4 * quad + (l15 >> 2)) * LP + 4 * (l15 & 3)) * 2) + (unsigned)(16 * vt * 2), vr);
#pragma unroll
                for (int t = 0; t < 4; ++t) {
                    const u32x4 aw = {vr[2 * t][0], vr[2 * t][1], vr[2 * t + 1][0], vr[2 * t + 1][1]};
                    o = MFMA16(__builtin_bit_cast(bf16x8, aw), Pb[t], o);
                }
            }
            O[vt] = o;
        }
        float s = 0.f;
#pragma unroll
        for (int vt = 0; vt < 8; ++vt) s += (O[vt][0] + O[vt][1]) + (O[vt][2] + O[vt][3]);
        s += __shfl_xor(s, 16); s += __shfl_xor(s, 32);
        const float mean = s * (1.0f / 128.0f); float q = 0.f;
#pragma unroll
        for (int vt = 0; vt < 8; ++vt) { O[vt] = O[vt] - mean; q += (O[vt][0] * O[vt][0] + O[vt][1] * O[vt][1]) + (O[vt][2] * O[vt][2] + O[vt][3] * O[vt][3]); }
        q += __shfl_xor(q, 16); q += __shfl_xor(q, 32);
        const float rstd = 1.0f / sqrtf(q * (1.0f / 128.0f) + LN_EPS);
        const bf16_t* grow = pj + (size_t)ii * ABN + 1536 + h * 128 + quad * 4;
        bf16_t* orow = MX + (size_t)(sl * SLAB + rowbase + ii) * D + h * 128 + quad * 4;
        u32x2 gwv[8];
#pragma unroll
        for (int vt = 0; vt < 8; ++vt) gwv[vt] = *(const u32x2*)(grow + 16 * vt);
#pragma unroll
        for (int vt = 0; vt < 8; ++vt) {
            const u32x2 gw = gwv[vt];
            const float g0 = bflo(gw.x), g1 = bfhi(gw.x), g2 = bflo(gw.y), g3 = bfhi(gw.y);
            const f32x4 y = O[vt] * rstd;
            u32x2 w; w.x = pk2(pg8::silu_f(g0) * y[0], pg8::silu_f(g1) * y[1]); w.y = pk2(pg8::silu_f(g2) * y[2], pg8::silu_f(g3) * y[3]);
            *(u32x2*)(orow + 16 * vt) = w;
        }
        __syncthreads();
    }
}

DI void phase_sgu(const Ctx& p, LAS unsigned char* lds, int c0, int cG, int uend) {
    int tid_ = threadIdx.x; asm volatile("" : "+v"(tid_));
    const int tid = tid_, lane = tid & 63, wave = tid >> 6, l15 = lane & 15, quad = lane >> 4;
    unsigned char* ws = p.wsp();
    const bf16_t* UV = (const bf16_t*)(ws + WS_S + S_UV); const bf16_t* SW = (const bf16_t*)(ws + WS_SGUW);
    bf16_t* MX = (bf16_t*)p.out();
    LAS bf16_t* VT = (LAS bf16_t*)lds;
    const int j = tid >> 2, part = tid & 3, ii = 16 * wave + l15;
    const unsigned trl = (unsigned)(((8 * quad + (l15 >> 2)) * LP + 4 * (l15 & 3)) * 2);
    for (int u = c0; u < uend; u += cG) {
        const int tok0 = u * 128;
        const bf16_t* vp = UV + (size_t)(tok0 + j) * D + 512 + part * 128;
        u32x4 v[16];
#pragma unroll
        for (int c = 0; c < 16; ++c) v[c] = *(const u32x4*)(vp + 8 * c);
        float s = 0.f, q = 0.f;
#pragma unroll
        for (int c = 0; c < 16; ++c)
#pragma unroll
            for (int e = 0; e < 4; ++e) { const float a = bflo(v[c][e]), b = bfhi(v[c][e]); s += a + b; q += a * a + b * b; }
        s += __shfl_xor(s, 1); s += __shfl_xor(s, 2); q += __shfl_xor(q, 1); q += __shfl_xor(q, 2);
        const float mean = s * (1.0f / 512.0f); const float rstd = 1.0f / sqrtf(fmaxf(q * (1.0f / 512.0f) - mean * mean, 0.f) + LN_EPS);
        {
            LAS bf16_t* vs = VT + part * VTS + j * LP;
#pragma unroll
            for (int c = 0; c < 16; ++c) {
                u32x4 o;
#pragma unroll
                for (int e2 = 0; e2 < 4; ++e2) o[e2] = pk2((bflo(v[c][e2]) - mean) * rstd, (bfhi(v[c][e2]) - mean) * rstd);
                *(LAS u32x4*)(vs + 8 * c) = o;
            }
        }
        bf16x8 Wb[4][4];
#pragma unroll
        for (int g = 0; g < 4; ++g)
#pragma unroll
            for (int js = 0; js < 4; ++js) Wb[g][js] = *(const bf16x8*)(SW + (size_t)(g * 128 + ii) * 128 + 32 * js + quad * 8);
        __syncthreads();
#pragma unroll
        for (int g = 0; g < 4; ++g) {
            float rsw = 0.f;
#pragma unroll
            for (int js = 0; js < 4; ++js)
#pragma unroll
                for (int e = 0; e < 8; ++e) rsw += bf2f((unsigned short)Wb[g][js][e]);
            rsw += __shfl_xor(rsw, 16); rsw += __shfl_xor(rsw, 32);
            const float bias = p.in(I_SB)[g * 128 + ii];
            const float* lg = p.in(I_SLG) + g * 128 + quad * 4; const float* lb = p.in(I_SLB) + g * 128 + quad * 4;
            const bf16_t* urow = UV + (size_t)(tok0 + ii) * D + g * 128 + quad * 4;
            bf16_t* orow = MX + (size_t)(tok0 + ii) * D + 512 + g * 128 + quad * 4;
#pragma unroll
            for (int hf = 0; hf < 2; ++hf) {
                u32x2 uwv[4]; f32x4 gvv[4], bvv[4];
#pragma unroll
                for (int q = 0; q < 4; ++q) { const int ct = 4 * hf + q; uwv[q] = *(const u32x2*)(urow + 16 * ct); gvv[q] = *(const f32x4*)(lg + 16 * ct); bvv[q] = *(const f32x4*)(lb + 16 * ct); }
#pragma unroll
                for (int q = 0; q < 4; ++q) {
                    const int ct = 4 * hf + q;
                    const u32x2 uw = uwv[q];
                    const f32x4 gv = gvv[q], bv = bvv[q];
                    f32x4 acc = {0.f, 0.f, 0.f, 0.f};
                    u32x2 vr[8]; tr_read8((unsigned)(g * VTS * 2) + trl + (unsigned)(16 * ct * 2), vr);
#pragma unroll
                    for (int js = 0; js < 4; ++js) { const u32x4 aw = {vr[2 * js][0], vr[2 * js][1], vr[2 * js + 1][0], vr[2 * js + 1][1]}; acc = MFMA16(__builtin_bit_cast(bf16x8, aw), Wb[g][js], acc); }
                    const f32x4 sg = acc * gv + bv * rsw + bias;
                    u32x2 w; w.x = pk2(bflo(uw.x) * sg[0], bfhi(uw.x) * sg[1]); w.y = pk2(bflo(uw.y) * sg[2], bfhi(uw.y) * sg[3]);
                    *(u32x2*)(orow + 16 * ct) = w;
                }
            }
        }
        __syncthreads();
    }
}

DI void run_phase(const Ctx& p, LAS unsigned char* lds, int ph) {
    unsigned char* ws = p.wsp();
    int G = gridDim.x, c = blockIdx.x; asm volatile("" : "+s"(G), "+s"(c));
    bf16_t* XB = (bf16_t*)(ws + WS_XB);
    StaticOrder S;
    int ffn = -1, sub = 0;
    if (ph >= 1 && ph <= 3) { ffn = 0; sub = ph - 1; }
    else if (ph >= 18 && ph <= 20) { ffn = 1; sub = ph - 18; }
    else if (ph >= 21 && ph <= 23) { ffn = 2; sub = ph - 21; }
    else if (ph >= 28 && ph <= 30) { ffn = 3; sub = ph - 28; }
    if (ph == 0) { phase_prep(p, lds); return; }
    if (ffn >= 0) {
        const int lnidx = (ffn == 0) ? 0 : (ffn == 1) ? 2 : (ffn == 2) ? 3 : 5;
        if (sub == 0) {
            Gemm g{XB, (const bf16_t*)(ws + WS_WGU + ffn * SZ_WGU), T, 5632, 1024, 1024, 1024}; S.init(g.M, g.N, G, c);
            pg8::EpiSwiglu E{(bf16_t*)(ws + WS_S + S_H)}; pg8::gemm_phase(lds, g, S, E);
        } else if (sub == 1) {
            Gemm g{(const bf16_t*)(ws + WS_S + S_H), (const bf16_t*)(ws + WS_WD + ffn * SZ_WD), T, 1024, FF, FF, FF}; S.init(g.M, g.N, G, c, 1);
            unsigned long long* st = (unsigned long long*)(ws + WS_LNS); const unsigned cn = (unsigned)lnidx + 1u;
            const float* gm = p.in(I_LNG) + lnidx * D; const float* bt = p.in(I_LNB) + lnidx * D;
            if (ffn == 0) { pg8::EpiLn<0> E{p.in(I_XP), p.in(I_XS), XB, 0.5f, gm, bt, st, cn, lds}; pg8::gemm_phase(lds, g, S, E); }
            else if (ffn == 3) { pg8::EpiLn<2> E{XB, XB, p.out(), 0.5f, gm, bt, st, cn, lds}; pg8::gemm_phase(lds, g, S, E); }
            else { pg8::EpiLn<1> E{XB, XB, XB, 0.5f, gm, bt, st, cn, lds}; pg8::gemm_phase(lds, g, S, E); }
        }
        return;
    }
    if (ph >= 4 && ph <= 15) {
        const int sl = (ph - 4) >> 2, k = (ph - 4) & 3;
        if (k == 0) { Gemm g{XB + (size_t)sl * SLAB * D, (const bf16_t*)(ws + WS_WABI), SLAB, ABN, 1024, 1024, 1024}; S.init(g.M, g.N, G, c);
            pg8::EpiBf16<0> E{(bf16_t*)(ws + WS_S + S_PJ), ABN}; pg8::gemm_phase(lds, g, S, E); }
        else if (k == 1) phase_r1(p, lds, sl);
        else if (k == 2) phase_r2(p);
        else phase_r3(p, lds, sl);
        return;
    }
    if (ph == 16 || ph == 26) {
        Gemm g{(const bf16_t*)p.out(), (const bf16_t*)(ws + (ph == 16 ? WS_WABO : WS_WCDO)), T, 1024, 1024, 1024, 1024}; S.init(g.M, g.N, G, c, 1);
        const int lnidx = ph == 16 ? 1 : 4;
        pg8::EpiLn<1> E{XB, XB, XB, 1.0f, p.in(I_LNG) + lnidx * D, p.in(I_LNB) + lnidx * D, (unsigned long long*)(ws + WS_LNS), (unsigned)lnidx + 1u, lds}; pg8::gemm_phase(lds, g, S, E); return;
    }
    if (ph == 24) {
        { Gemm g{(const bf16_t*)(ws + WS_WF1), XB, 1024, T, 1024, 1024, 1024}; S.init(g.M, g.N, G, c); pg8::EpiF1 E{(bf16_t*)(ws + WS_S + S_GT)}; pg8::gemm_phase(lds, g, S, E); }
        { Gemm g{XB, (const bf16_t*)(ws + WS_WUV), T, 1024, 1024, 1024, 1024}; S.init(g.M, g.N, G, c); pg8::EpiBf16<1> E{(bf16_t*)(ws + WS_S + S_UV), 1024}; pg8::gemm_phase(lds, g, S, E); }
        return;
    }
    if (ph == 25) {
        {   Gemm g{(const bf16_t*)(ws + WS_DFT), (const bf16_t*)(ws + WS_S + S_GT), 4096, 6144, 4096, 4096, 8192};
            pg8::F2Order FO{G, c}; pg8::EpiF2 E{(bf16_t*)p.out(), (float*)(ws + WS_S + S_F2P) + (size_t)c * 65536}; pg8::gemm_phase(lds, g, FO, E); }
        if (G == 256) { if (c >= 192) phase_sgu(p, lds, c - 192, 64, 384); }
        else phase_sgu(p, lds, c, G, 384);
        const int c0 = c, cG = G;
        if (c0 >= 0) {
            int tq = threadIdx.x; asm volatile("" : "+v"(tq)); const int lane = tq & 63, wave = tq >> 6; const bf16_t* GT = (const bf16_t*)(ws + WS_S + S_GT); bf16_t* MX = (bf16_t*)p.out();
            for (int col = c0 * 8 + wave; col < 6144; col += cG * 8) {
                const u32x4* gp = (const u32x4*)(GT + (size_t)col * 8192) + lane; float sacc = 0.f;
#pragma unroll
                for (int j = 0; j < 8; ++j) { const u32x4 v = gp[64 * j];
#pragma unroll
                    for (int e = 0; e < 4; ++e) sacc += bflo(v[e]) - bfhi(v[e]); }
#pragma unroll
                for (int o = 1; o < 64; o <<= 1) sacc += __shfl_xor(sacc, o);
                if (lane == 0) MX[(size_t)((col >> 9) * 4096 + 2048) * 1024 + (col & 511)] = f2bf(sacc * FSCALE);
            }
        }
        return;
    }
}

__global__ void __launch_bounds__(512, 2) fwd_megakernel(Params p) {
    extern __shared__ __attribute__((aligned(16))) unsigned char lds_raw[];
    LAS unsigned char* lds = (LAS unsigned char*)lds_raw;
    cg::grid_group grid = cg::this_grid();
    Ctx C; C.tab = (LAS unsigned long long*)(lds + LDS_MISC);
    volatile LAS unsigned* xst = (volatile LAS unsigned*)(lds + LDS_MISC + 512);
    if (threadIdx.x == 0) {
#pragma unroll
        for (int i = 0; i < 18; ++i) C.tab[i] = (unsigned long long)p.in[i];
        C.tab[18] = (unsigned long long)p.out; C.tab[19] = (unsigned long long)p.ws;
        xst[0] = 0u; xst[1] = 0u; xst[2] = 0u;
    }
    __syncthreads();
    xcd_barrier_post((unsigned*)(p.ws + WS_BAR), xst);
    const int ph_hi = p.ph_hi;
    for (int ph = p.ph_lo; ph < ph_hi; ++ph) {
        if (ph == 3 || ph == 17 || ph == 20 || ph == 23 || ph == 27 || ph == 30) continue;
        run_phase(C, lds, ph);
        if (ph + 1 < ph_hi) {
            if (ph_hi < 0) grid.sync();
            else xcd_barrier((unsigned*)(C.wsp() + WS_BAR), xst);
        }
    }
}

extern "C" void kernel_launch(void* const* d_in, const int* in_sizes, int n_in, void* d_out, int out_size, void* d_ws, size_t ws_size, hipStream_t stream) {
    static int grid_blocks = 0;
    if (grid_blocks == 0) {
        if (n_in != 18 || out_size != T * D || ws_size < WS_END) { fprintf(stderr, "kernel_launch: unexpected shapes (n_in %d out %d ws %zu need %zu)\n", n_in, out_size, ws_size, (size_t)WS_END); grid_blocks = -1; return; }
        int dev = 0, cus = 0, per_cu = 0;
        hipGetDevice(&dev);
        hipDeviceGetAttribute(&cus, hipDeviceAttributeMultiprocessorCount, dev);
        if (hipFuncSetAttribute((const void*)fwd_megakernel, hipFuncAttributeMaxDynamicSharedMemorySize, LDS_BYTES) != hipSuccess) { fprintf(stderr, "kernel_launch: hipFuncSetAttribute failed\n"); grid_blocks = -1; return; }
        hipOccupancyMaxActiveBlocksPerMultiprocessor(&per_cu, (const void*)fwd_megakernel, 512, LDS_BYTES);
        if (per_cu < 1) { fprintf(stderr, "kernel_launch: occupancy query says %d blocks per CU\n", per_cu); per_cu = 1; }
        grid_blocks = cus;
        if (cus != 256) fprintf(stderr, "kernel_launch: built for 256 CUs (the fused LayerNorm epilogues pair workgroups by round); this device reports %d\n", cus);
    }
    if (grid_blocks < 0) return;
    if (hipMemsetAsync((char*)d_ws + WS_BAR, 0, ZERO_BYTES, stream) != hipSuccess || hipMemsetAsync((char*)d_ws + WS_LNS, 0, ZERO2_BYTES, stream) != hipSuccess) { fprintf(stderr, "kernel_launch: memset failed\n"); return; }
    Params p{};
    for (int i = 0; i < 18; ++i) p.in[i] = (const float*)d_in[i];
    p.out = (float*)d_out; p.ws = (unsigned char*)d_ws;
    p.ph_lo = 0; p.ph_hi = NPHASE;
    void* args[] = {&p};
    hipError_t e = hipLaunchCooperativeKernel((const void*)fwd_megakernel, dim3(grid_blocks), dim3(512), args, LDS_BYTES, stream);
    if (e != hipSuccess) fprintf(stderr, "cooperative launch failed: %s (grid %d)\n", hipGetErrorString(e), grid_blocks);
}
```

```cpp
#include <hip/hip_runtime.h>
#include <hip/hip_cooperative_groups.h>
#include <cstdio>
#include <cstdint>
namespace cg = cooperative_groups;


#define DI __device__ __forceinline__
#define LAS __attribute__((address_space(3)))
typedef unsigned short bf16_t;
typedef short bf16x8 __attribute__((ext_vector_type(8)));
typedef short s16x4 __attribute__((ext_vector_type(4)));
typedef float f32x4 __attribute__((ext_vector_type(4)));
typedef float f32x2 __attribute__((ext_vector_type(2)));
typedef unsigned u32x4 __attribute__((ext_vector_type(4)));
typedef unsigned u32x2 __attribute__((ext_vector_type(2)));

constexpr int T = 49152, TP = 32768, D = 1024, FF = 2816, SEQ = 4096;
constexpr int ABN = 3584;
constexpr int SLAB = 16384;
constexpr float DN_ALPHA = 1.41421356237309515f;
constexpr float LN_EPS = 1e-5f;
constexpr float KSCALE = 0.08838834764831845f;
constexpr float FSCALE = 0.0013810679320049757f;
constexpr int VTS = 17424;
constexpr int LDS_MISC = 4 * VTS * 2;
constexpr int LDS_LNP = 131072;
constexpr int LDS_LNS = LDS_MISC + 1024;
constexpr int LDS_BYTES = LDS_MISC + 1024 + 2048;
constexpr int NPHASE = 31;

constexpr size_t SZ_WGU = (size_t)5632 * 1024 * 2, SZ_WD = (size_t)1024 * 2816 * 2, SZ_SQ = (size_t)1024 * 1024 * 2;
constexpr size_t WS_WGU = 0;
constexpr size_t WS_WD = WS_WGU + 4 * SZ_WGU;
constexpr size_t WS_WABI = WS_WD + 4 * SZ_WD;
constexpr size_t WS_WABO = WS_WABI + (size_t)ABN * 1024 * 2;
constexpr size_t WS_WF1 = WS_WABO + SZ_SQ;
constexpr size_t WS_WUV = WS_WF1 + SZ_SQ;
constexpr size_t WS_WCDO = WS_WUV + SZ_SQ;
constexpr size_t WS_SGUW = WS_WCDO + SZ_SQ;
constexpr size_t WS_DFT = WS_SGUW + (size_t)4 * 128 * 128 * 2;
constexpr size_t WS_ROPE = WS_DFT + (size_t)4096 * 8192 * 2;
constexpr size_t WS_XB = WS_ROPE + (size_t)2 * 4096 * 64 * 4;
constexpr size_t WS_S = WS_XB + (size_t)T * D * 2;
constexpr size_t S_H = 0;
constexpr size_t S_PJ = 0;
constexpr size_t S_KV = S_PJ + (size_t)SLAB * ABN * 2;
constexpr size_t S_ST = S_KV + (size_t)512 * 2 * 16384 * 4;
constexpr size_t S_GT = 0;
constexpr size_t S_UV = S_GT + (size_t)6144 * 8192 * 2;
constexpr size_t S_F2P = S_UV + (size_t)T * D * 2;
constexpr size_t WS_BAR = WS_S + (size_t)T * FF * 2;
constexpr size_t WS_LNS = WS_BAR + 16384;
constexpr size_t SZ_LNS = (size_t)T * 4 * 8;
constexpr size_t WS_LNC = WS_LNS + SZ_LNS;
constexpr size_t WS_END = WS_LNC + 6 * 1024;
constexpr size_t ZERO_BYTES = 16384;
constexpr size_t ZERO2_BYTES = SZ_LNS;

typedef __bf16 hwbf16x2 __attribute__((ext_vector_type(2)));
DI unsigned pk2(float lo, float hi) { const f32x2 v = {lo, hi}; return __builtin_bit_cast(unsigned, __builtin_convertvector(v, hwbf16x2)); }
DI unsigned short f2bf(float f) { return (unsigned short)(pk2(f, 0.f) & 0xffffu); }
DI float bf2f(unsigned short b) { return __uint_as_float(((unsigned)b) << 16); }
DI float bflo(unsigned w) { return __uint_as_float(w << 16); }
DI float bfhi(unsigned w) { return __uint_as_float(w & 0xffff0000u); }
#define LDS_WAIT() asm volatile("s_waitcnt lgkmcnt(0)" ::: "memory")

namespace pg8 {
constexpr int BM = 256, BK = 64, HALF = 128, HTB = HALF * BK * 2, STAGE_BYTES = 8 * HTB, NXCD = 8, WGM = 8;
__host__ __device__ __forceinline__ int lds_byte(int r, int c) { const int st = (r >> 4) * 2 + (c >> 5), rr = r & 15, cc = c & 31, ob = rr * 64 + cc * 2; return st * 1024 + (ob ^ (((ob >> 9) & 1) << 5)); }
__host__ __device__ __forceinline__ void stage_rc(int b, int& R, int& C) { const int st = b / 1024, sb = b % 1024, swz = sb ^ (((sb >> 9) & 1) << 5); R = (st >> 1) * 16 + swz / 64; C = (st & 1) * 32 + (swz % 64) / 2; }
__host__ __device__ __forceinline__ int perm32(int rho) { const int n = rho >> 4, i = rho & 15; return 8 * (i >> 2) + 4 * n + (i & 3); }
struct Unit { int pm, pn; };
struct Gemm { const bf16_t* A; const bf16_t* Bt; int M, N, K, lda, ldb; };
struct StaticOrder {
    int nM, nN, nwg, G, c, pnfast;
    __device__ void init(int M, int N, int G_, int c_, int pnfast_ = 0) { nM = M / BM; nN = N / BM; nwg = nM * nN; G = G_; c = c_; pnfast = pnfast_; }
    __device__ bool next(int i, Unit& u) const {
        const long L = (long)i * G + c; if (L >= nwg) return false;
        int wgid = (int)L; { const int q = nwg / NXCD, r = nwg % NXCD, xcd = wgid % NXCD, off = wgid / NXCD; wgid = (xcd < r ? xcd * (q + 1) : r * (q + 1) + (xcd - r) * q) + off; }
        const int nig = WGM * nN, gid = wgid / nig, fm = gid * WGM, gsz = (nM - fm) < WGM ? (nM - fm) : WGM;
        if (pnfast) { u.pn = (wgid % nig) % nN; u.pm = fm + (wgid % nig) / nN; }
        else { u.pm = fm + ((wgid % nig) % gsz); u.pn = (wgid % nig) / gsz; }
        return true;
    }
    __device__ size_t boff(const Unit&) const { return 0; }
};
struct F2Order {
    int G, c;
    __device__ bool next(int i, Unit& u) const { const int su = c + (i >> 1) * G; if (su >= 192) return false; u.pm = (su & 7) + 8 * (i & 1); u.pn = su >> 3; return true; }
    __device__ size_t boff(const Unit& u) const { return u.pm >= 8 ? (size_t)4096 * 2 : 0; }
};
DI unsigned cvt_pk_bf16(float lo, float hi) { unsigned r; asm volatile("v_cvt_pk_bf16_f32 %0, %1, %2" : "=v"(r) : "v"(lo), "v"(hi)); return r; }

DI float silu_f(float g) { return g * __builtin_amdgcn_rcpf(1.0f + __expf(-g)); }
DI f32x4 swiglu4(f32x4 g, f32x4 u) {
    f32x4 t = g * (-1.4426950408889634f), e;
#pragma unroll
    for (int i = 0; i < 4; ++i) e[i] = __builtin_amdgcn_exp2f(fminf(t[i], 30.0f));
    const f32x4 a = e + 1.0f;
    const float P = a[0] * a[1], Q = a[2] * a[3], R = __builtin_amdgcn_rcpf(P * Q), QR = Q * R, PR = P * R;
    const f32x4 inv = {a[1] * QR, a[0] * QR, a[3] * PR, a[2] * PR};
    return g * u * inv;
}
DI float gelu_tanh_f(float x) { const float y = 0.7978845608028654f * (x + 0.044715f * x * x * x); return x * __builtin_amdgcn_rcpf(1.0f + __expf(-2.0f * y)); }

struct EpiSwiglu {
    static constexpr bool PERM = true, ALIGN = false;
    bf16_t* H;
    DI void operator()(const f32x4 (&acc)[2][2][4][2], const Unit& u, int wr, int wc, int fr, int fq) const {
        const int row0 = u.pm * BM + wr * 64 + fr, col0 = u.pn * 128 + wc * 32 + 8 * fq;
#pragma unroll
        for (int ai = 0; ai < 2; ++ai)
#pragma unroll
            for (int m = 0; m < 4; ++m) {
                bf16_t* rowp = H + (size_t)(row0 + ai * HALF + m * 16) * FF + col0;
                const f32x4 h0 = swiglu4(acc[ai][0][m][0], acc[ai][1][m][0]), h1 = swiglu4(acc[ai][0][m][1], acc[ai][1][m][1]);
                u32x4 w; w.x = cvt_pk_bf16(h0[0], h0[1]); w.y = cvt_pk_bf16(h0[2], h0[3]); w.z = cvt_pk_bf16(h1[0], h1[1]); w.w = cvt_pk_bf16(h1[2], h1[3]);
                *(u32x4*)rowp = w;
            }
    }
};
template <int ACT> struct EpiBf16 {
    static constexpr bool PERM = true, ALIGN = false;
    bf16_t* O; int ldc;
    DI void operator()(const f32x4 (&acc)[2][2][4][2], const Unit& u, int wr, int wc, int fr, int fq) const {
        const int row0 = u.pm * BM + wr * 64 + fr, col0 = u.pn * BM + wc * 32 + 8 * fq;
#pragma unroll
        for (int ai = 0; ai < 2; ++ai)
#pragma unroll
            for (int m = 0; m < 4; ++m) {
                bf16_t* rowp = O + (size_t)(row0 + ai * HALF + m * 16) * ldc + col0;
#pragma unroll
                for (int bj = 0; bj < 2; ++bj) {
                    f32x4 v0 = acc[ai][bj][m][0], v1 = acc[ai][bj][m][1];
                    if (ACT == 1) {
#pragma unroll
                        for (int j = 0; j < 4; ++j) { v0[j] = gelu_tanh_f(v0[j]); v1[j] = gelu_tanh_f(v1[j]); }
                    }
                    u32x4 w; w.x = cvt_pk_bf16(v0[0], v0[1]); w.y = cvt_pk_bf16(v0[2], v0[3]); w.z = cvt_pk_bf16(v1[0], v1[1]); w.w = cvt_pk_bf16(v1[2], v1[3]);
                    *(u32x4*)(rowp + bj * HALF) = w;
                }
            }
    }
};
template <bool BF16BASE> struct EpiResid {
    static constexpr bool PERM = true, ALIGN = false;
    const void* base0; const void* base1; float* out; float scale;
    DI void operator()(const f32x4 (&acc)[2][2][4][2], const Unit& u, int wr, int wc, int fr, int fq) const {
        const int row0 = u.pm * BM + wr * 64 + fr, col0 = u.pn * BM + wc * 32 + 8 * fq;
#pragma unroll
        for (int ai = 0; ai < 2; ++ai)
#pragma unroll
            for (int m = 0; m < 4; ++m) {
                const int r = row0 + ai * HALF + m * 16;
                float* op = out + (size_t)r * D + col0;
                if (BF16BASE) {
                    const bf16_t* bp = (const bf16_t*)base0 + (size_t)r * D + col0;
#pragma unroll
                    for (int bj = 0; bj < 2; ++bj) { const u32x4 w = *(const u32x4*)(bp + bj * HALF);
                        const f32x4 b0 = {bflo(w.x), bfhi(w.x), bflo(w.y), bfhi(w.y)}, b1 = {bflo(w.z), bfhi(w.z), bflo(w.w), bfhi(w.w)};
                        *(f32x4*)(op + bj * HALF) = b0 * DN_ALPHA + acc[ai][bj][m][0] * scale; *(f32x4*)(op + bj * HALF + 4) = b1 * DN_ALPHA + acc[ai][bj][m][1] * scale; }
                } else {
                    const float* bp = (r < TP ? (const float*)base0 + (size_t)r * D : (const float*)base1 + (size_t)(r - TP) * D) + col0;
#pragma unroll
                    for (int bj = 0; bj < 2; ++bj) { const f32x4 b0 = *(const f32x4*)(bp + bj * HALF), b1 = *(const f32x4*)(bp + bj * HALF + 4);
                        *(f32x4*)(op + bj * HALF) = b0 * DN_ALPHA + acc[ai][bj][m][0] * scale; *(f32x4*)(op + bj * HALF + 4) = b1 * DN_ALPHA + acc[ai][bj][m][1] * scale; }
                }
            }
    }
};

template <int MODE> struct EpiLn {
    static constexpr bool PERM = true, ALIGN = true;
    const void* base0; const void* base1; void* out; float scale; const float* gam; const float* bet; unsigned long long* xs; unsigned tag; LAS unsigned char* lds;
    DI void operator()(f32x4 (&acc)[2][2][4][2], const Unit& u, int wr, int wc, int fr, int fq) const {
        const int row0 = u.pm * BM + wr * 64 + fr, col0 = u.pn * BM + wc * 32 + 8 * fq;
        LAS f32x2* P = (LAS f32x2*)(lds + LDS_LNP); LAS f32x2* Sx = (LAS f32x2*)(lds + LDS_LNS);
        const int tid = (wr * 4 + wc) * 64 + fq * 16 + fr;
#pragma unroll
        for (int ai = 0; ai < 2; ++ai) {
            u32x4 bw[4][2];
            if (MODE != 0) {
#pragma unroll
                for (int m = 0; m < 4; ++m)
#pragma unroll
                    for (int bj = 0; bj < 2; ++bj) bw[m][bj] = *(const u32x4*)((const bf16_t*)base0 + (size_t)(row0 + ai * HALF + m * 16) * D + col0 + bj * HALF);
            }
#pragma unroll
            for (int m = 0; m < 4; ++m) {
                const int r = row0 + ai * HALF + m * 16;
                float s = 0.f, q = 0.f;
#pragma unroll
                for (int bj = 0; bj < 2; ++bj) {
                    f32x4 b0, b1;
                    if (MODE == 0) { const float* bp = (r < TP ? (const float*)base0 + (size_t)r * D : (const float*)base1 + (size_t)(r - TP) * D) + col0 + bj * HALF; b0 = *(const f32x4*)bp; b1 = *(const f32x4*)(bp + 4); }
                    else { const u32x4 w = bw[m][bj];
                        b0 = (f32x4){bflo(w.x), bfhi(w.x), bflo(w.y), bfhi(w.y)}; b1 = (f32x4){bflo(w.z), bfhi(w.z), bflo(w.w), bfhi(w.w)}; }
                    const f32x4 z0 = b0 * DN_ALPHA + acc[ai][bj][m][0] * scale, z1 = b1 * DN_ALPHA + acc[ai][bj][m][1] * scale;
                    acc[ai][bj][m][0] = z0; acc[ai][bj][m][1] = z1;
                    s += ((z0[0] + z0[1]) + (z0[2] + z0[3])) + ((z1[0] + z1[1]) + (z1[2] + z1[3]));
                    q += ((z0[0] * z0[0] + z0[1] * z0[1]) + (z0[2] * z0[2] + z0[3] * z0[3])) + ((z1[0] * z1[0] + z1[1] * z1[1]) + (z1[2] * z1[2] + z1[3] * z1[3]));
                }
                s += __shfl_xor(s, 16); s += __shfl_xor(s, 32); q += __shfl_xor(q, 16); q += __shfl_xor(q, 32);
                if (fq == 0) P[(ai * HALF + wr * 64 + m * 16 + fr) * 4 + wc] = (f32x2){s, q};
                if (MODE == 0 && (m & 1)) asm volatile("" ::: "memory");
            }
            asm volatile("" ::: "memory");
        }
        asm volatile("s_waitcnt lgkmcnt(0)" ::: "memory"); __builtin_amdgcn_s_barrier(); asm volatile("" ::: "memory");
        if (tid < 256) {
            const f32x2 a = P[tid * 4 + 0], b = P[tid * 4 + 1], c = P[tid * 4 + 2], d = P[tid * 4 + 3];
            const float S = (a[0] + b[0]) + (c[0] + d[0]), Q = (a[1] + b[1]) + (c[1] + d[1]);
            unsigned long long* slot = xs + (size_t)u.pm * 4 * BM + tid;
            __hip_atomic_store(slot + u.pn * BM, ((unsigned long long)((__float_as_uint(Q) & ~7u) | tag) << 32) | __float_as_uint(S), __ATOMIC_RELAXED, __HIP_MEMORY_SCOPE_AGENT);
            unsigned long long w[4]; unsigned polls = 0;
            const unsigned long long* s0 = slot; const unsigned long long* s1 = slot + BM; const unsigned long long* s2 = slot + 2 * BM; const unsigned long long* s3 = slot + 3 * BM;
            for (;;) {
                u32x2 l0, l1, l2, l3;
                asm volatile("global_load_dwordx2 %0, %4, off sc1\n\tglobal_load_dwordx2 %1, %5, off sc1\n\tglobal_load_dwordx2 %2, %6, off sc1\n\tglobal_load_dwordx2 %3, %7, off sc1\n\ts_waitcnt vmcnt(0)"
                             : "=&v"(l0), "=&v"(l1), "=&v"(l2), "=&v"(l3) : "v"(s0), "v"(s1), "v"(s2), "v"(s3) : "memory");
                w[0] = ((unsigned long long)l0[1] << 32) | l0[0]; w[1] = ((unsigned long long)l1[1] << 32) | l1[0];
                w[2] = ((unsigned long long)l2[1] << 32) | l2[0]; w[3] = ((unsigned long long)l3[1] << 32) | l3[0];
                const bool ok = ((l0[1] & 7u) == tag) && ((l1[1] & 7u) == tag) && ((l2[1] & 7u) == tag) && ((l3[1] & 7u) == tag);
                if (__builtin_amdgcn_ballot_w64(!ok) == 0ull) break;
                __builtin_amdgcn_s_sleep(24); if (++polls > (1u << 20)) break;
            }
            float S4 = 0.f, Q4 = 0.f;
#pragma unroll
            for (int t = 0; t < 4; ++t) { S4 += __uint_as_float((unsigned)w[t]); Q4 += __uint_as_float((unsigned)(w[t] >> 32) & ~7u); }
            const float mean = S4 * (1.0f / D);
            Sx[tid] = (f32x2){mean, 1.0f / sqrtf(fmaxf(Q4 * (1.0f / D) - mean * mean, 0.f) + LN_EPS)};
        }
        asm volatile("s_waitcnt lgkmcnt(0)" ::: "memory"); __builtin_amdgcn_s_barrier(); asm volatile("" ::: "memory");
        f32x4 gq[2][2], eq[2][2];
#pragma unroll
        for (int bj = 0; bj < 2; ++bj) { const int c = col0 + bj * HALF; gq[bj][0] = *(const f32x4*)(gam + c); gq[bj][1] = *(const f32x4*)(gam + c + 4); eq[bj][0] = *(const f32x4*)(bet + c); eq[bj][1] = *(const f32x4*)(bet + c + 4); }
#pragma unroll
        for (int ai = 0; ai < 2; ++ai)
#pragma unroll
            for (int m = 0; m < 4; ++m) {
                int rl = ai * HALF + wr * 64 + m * 16 + fr; asm volatile("" : "+v"(rl));
                const f32x2 sr = Sx[rl]; const float mean = sr[0], rstd = sr[1];
                const size_t r = (size_t)(u.pm * BM + rl);
#pragma unroll
                for (int bj = 0; bj < 2; ++bj) {
                    const int c = col0 + bj * HALF;
                    const f32x4 g0 = gq[bj][0], g1 = gq[bj][1], e0 = eq[bj][0], e1 = eq[bj][1];
                    const f32x4 y0 = (acc[ai][bj][m][0] - mean) * rstd * g0 + e0, y1 = (acc[ai][bj][m][1] - mean) * rstd * g1 + e1;
                    if (MODE == 2) { float* op = (float*)out + r * D + c; *(f32x4*)op = y0; *(f32x4*)(op + 4) = y1; }
                    else { u32x4 o; o.x = cvt_pk_bf16(y0[0], y0[1]); o.y = cvt_pk_bf16(y0[2], y0[3]); o.z = cvt_pk_bf16(y1[0], y1[1]); o.w = cvt_pk_bf16(y1[2], y1[3]);
                        *(u32x4*)((bf16_t*)out + r * D + c) = o; }
                }
            }
    }
};
struct EpiF1 {
    static constexpr bool PERM = true, ALIGN = false;
    bf16_t* Gt;
    DI void operator()(const f32x4 (&acc)[2][2][4][2], const Unit& u, int wr, int wc, int fr, int fq) const {
        const int row0 = u.pm * BM + wr * 64 + fr, tok0 = u.pn * BM + wc * 32 + 8 * fq;
        const int b = tok0 >> 12, s = tok0 & 4095;
#pragma unroll
        for (int ai = 0; ai < 2; ++ai)
#pragma unroll
            for (int m = 0; m < 4; ++m) {
                const int lp = row0 + ai * HALF + m * 16, ri = lp >> 9, g = (lp >> 7) & 3, l = lp & 127;
                bf16_t* rowp = Gt + (size_t)((b * 4 + g) * 128 + l) * 8192 + ri * 4096 + s;
#pragma unroll
                for (int bj = 0; bj < 2; ++bj) {
                    const f32x4 v0 = acc[ai][bj][m][0], v1 = acc[ai][bj][m][1];
                    u32x4 w; w.x = cvt_pk_bf16(v0[0], v0[1]); w.y = cvt_pk_bf16(v0[2], v0[3]); w.z = cvt_pk_bf16(v1[0], v1[1]); w.w = cvt_pk_bf16(v1[2], v1[3]);
                    *(u32x4*)(rowp + bj * HALF) = w;
                }
            }
    }
};
struct EpiF2 {
    static constexpr bool PERM = true, ALIGN = false;
    bf16_t* MX; float* part;
    DI void operator()(const f32x4 (&acc)[2][2][4][2], const Unit& u, int wr, int wc, int fr, int fq) const {
        const int tid = (wr * 4 + wc) * 64 + fq * 16 + fr;
        f32x4* sp = (f32x4*)part + tid;
        if (u.pm < 8) {
#pragma unroll
            for (int ai = 0; ai < 2; ++ai)
#pragma unroll
                for (int m = 0; m < 4; ++m) {
                    f32x4* sq = sp + (ai * 4 + m) * 4 * 512; asm volatile("" : "+v"(sq));
#pragma unroll
                    for (int bj = 0; bj < 2; ++bj)
#pragma unroll
                        for (int n = 0; n < 2; ++n) sq[(bj * 2 + n) * 512] = acc[ai][bj][m][n];
                }
            return;
        }
        const int row0 = (u.pm - 8) * BM + wr * 64 + fr, cc0 = u.pn * BM + wc * 32 + 8 * fq;
#pragma unroll
        for (int ai = 0; ai < 2; ++ai)
#pragma unroll
            for (int m = 0; m < 4; ++m) {
                int k = row0 + ai * HALF + m * 16; asm volatile("" : "+v"(k));
                const f32x4* sq = sp + (ai * 4 + m) * 4 * 512; asm volatile("" : "+v"(sq));
#pragma unroll
                for (int bj = 0; bj < 2; ++bj) {
                    const int cc = cc0 + bj * HALF, b = cc >> 9, within = cc & 511;
                    const f32x4 c0 = sq[(bj * 2 + 0) * 512], c1 = sq[(bj * 2 + 1) * 512];
                    const f32x4 p0 = (c0 + acc[ai][bj][m][0]) * FSCALE, p1 = (c1 + acc[ai][bj][m][1]) * FSCALE;
                    const f32x4 q0 = (c0 - acc[ai][bj][m][0]) * FSCALE, q1 = (c1 - acc[ai][bj][m][1]) * FSCALE;
                    u32x4 w; w.x = cvt_pk_bf16(p0[0], p0[1]); w.y = cvt_pk_bf16(p0[2], p0[3]); w.z = cvt_pk_bf16(p1[0], p1[1]); w.w = cvt_pk_bf16(p1[2], p1[3]);
                    *(u32x4*)(MX + (size_t)(b * 4096 + k) * 1024 + within) = w;
                    if (k > 0) { u32x4 v; v.x = cvt_pk_bf16(q0[0], q0[1]); v.y = cvt_pk_bf16(q0[2], q0[3]); v.z = cvt_pk_bf16(q1[0], q1[1]); v.w = cvt_pk_bf16(q1[2], q1[3]);
                        *(u32x4*)(MX + (size_t)(b * 4096 + 4096 - k) * 1024 + within) = v; }
                }
                asm volatile("" ::: "memory");
            }
    }
};

template <class Epi, class Sched>
__device__ __forceinline__ void gemm_phase(LAS unsigned char* lds, const Gemm g, const Sched& S, const Epi& E) {
    int tid_ = threadIdx.x; asm volatile("" : "+v"(tid_));
    const int tid = tid_, wid = __builtin_amdgcn_readfirstlane(tid >> 6), lane = tid & 63, wr = wid >> 2, wc = wid & 3, fr = lane & 15, fq = lane >> 4;
    const int K = g.K, nt = K / BK;
    unsigned voffA[2], voffB[2];
#pragma unroll
    for (int i = 0; i < 2; ++i) { int R, C; stage_rc(tid * 16 + i * 8192, R, C); const int Rb = Epi::PERM ? ((R & ~31) + perm32(R & 31)) : R;
        voffA[i] = (unsigned)(R * g.lda + C) * 2u; voffB[i] = (unsigned)(Rb * g.ldb + C) * 2u; }
    const size_t kstep = (size_t)(BK * 2);
    const size_t hstepA = (size_t)HALF * g.lda * 2, hstepB = (size_t)HALF * g.ldb * 2;
    const unsigned ldsw = (unsigned)wid * 1024u;
    const int aoff = lds_byte(wr * 64 + fr, fq * 8), boff = lds_byte(wc * 32 + fr, fq * 8);
#define PG8_SA(b, h) (((b) * 2 + (h)) * HTB)
#define PG8_SB(b, h) ((4 + (b) * 2 + (h)) * HTB)
#define PG8_STAGE(bufoff, gbase, voff) do { _Pragma("unroll") for (int _i = 0; _i < 2; ++_i) \
        __builtin_amdgcn_global_load_lds((const unsigned*)((const char*)(gbase) + (voff)[_i]), (LAS unsigned*)(lds + (bufoff) + ldsw + _i * 8192), 16, 0, 0); } while (0)
#define PG8_LDA(dst, b, h) do { _Pragma("unroll") for (int m = 0; m < 4; ++m) _Pragma("unroll") for (int k = 0; k < 2; ++k) dst[m][k] = *(const LAS bf16x8*)(lds + PG8_SA(b, h) + aoff + m * 2048 + k * 1024); } while (0)
#define PG8_LDB(dst, b, h) do { _Pragma("unroll") for (int n = 0; n < 2; ++n) _Pragma("unroll") for (int k = 0; k < 2; ++k) dst[n][k] = *(const LAS bf16x8*)(lds + PG8_SB(b, h) + boff + n * 2048 + k * 1024); } while (0)
#define PG8_MMA(ai, bj, At, Bt) do { __builtin_amdgcn_s_setprio(1); _Pragma("unroll") for (int m = 0; m < 4; ++m) _Pragma("unroll") for (int n = 0; n < 2; ++n) _Pragma("unroll") for (int k = 0; k < 2; ++k) \
        acc[ai][bj][m][n] = __builtin_amdgcn_mfma_f32_16x16x32_bf16(Bt[n][k], At[m][k], acc[ai][bj][m][n], 0, 0, 0); __builtin_amdgcn_s_setprio(0); } while (0)
#define PG8_WAIT_V(n) asm volatile("s_waitcnt vmcnt(" #n ")" ::: "memory")
#define PG8_WAIT_L(n) asm volatile("s_waitcnt lgkmcnt(" #n ")" ::: "memory")
#define PG8_BAR __builtin_amdgcn_s_barrier()
#define PG8_SCHED __builtin_amdgcn_sched_barrier(0)
    Unit cur, nxt; int ui = 0;
    if (!S.next(0, cur)) return;
    f32x4 acc[2][2][4][2];
#pragma unroll
    for (int a = 0; a < 2; ++a)
#pragma unroll
        for (int b = 0; b < 2; ++b)
#pragma unroll
            for (int m = 0; m < 4; ++m)
#pragma unroll
                for (int n = 0; n < 2; ++n) acc[a][b][m][n] = (f32x4){0.f, 0.f, 0.f, 0.f};
    bf16x8 At[4][2], B0[2][2], B1[2][2];
    const char* cA = (const char*)g.A + (size_t)cur.pm * 2 * hstepA; const char* cB = (const char*)g.Bt + (size_t)cur.pn * 2 * hstepB + S.boff(cur);
    PG8_STAGE(PG8_SB(0, 0), cB, voffB); PG8_STAGE(PG8_SA(0, 0), cA, voffA); PG8_STAGE(PG8_SB(0, 1), cB + hstepB, voffB); PG8_STAGE(PG8_SA(0, 1), cA + hstepA, voffA);
    if (wr == 1) PG8_BAR;
    PG8_WAIT_V(4); PG8_BAR;
    PG8_STAGE(PG8_SB(1, 0), cB + kstep, voffB); PG8_STAGE(PG8_SA(1, 0), cA + kstep, voffA); PG8_STAGE(PG8_SB(1, 1), cB + hstepB + kstep, voffB);
    PG8_WAIT_V(6); PG8_BAR;
    for (;;) {
        const bool has_next = S.next(ui + 1, nxt);
        const char* nA = has_next ? (const char*)g.A + (size_t)nxt.pm * 2 * hstepA : cA; const char* nB = has_next ? (const char*)g.Bt + (size_t)nxt.pn * 2 * hstepB + S.boff(nxt) : cB;
        for (int t = 0; t < nt; t += 2) {
            const bool last = (t == nt - 2);
            const char* a1 = cA + (size_t)(t + 1) * kstep;
            const char* a2 = last ? nA : cA + (size_t)(t + 2) * kstep; const char* b2 = last ? nB : cB + (size_t)(t + 2) * kstep;
            const char* a3 = a2 + kstep; const char* b3 = b2 + kstep;
            PG8_LDB(B0, 0, 0); PG8_SCHED; PG8_LDA(At, 0, 0); PG8_STAGE(PG8_SA(1, 1), a1 + hstepA, voffA);
            PG8_WAIT_L(8); PG8_BAR; PG8_WAIT_L(0); PG8_MMA(0, 0, At, B0); PG8_BAR; PG8_SCHED;
            PG8_LDB(B1, 0, 1); PG8_STAGE(PG8_SB(0, 0), b2, voffB);
            PG8_BAR; PG8_WAIT_L(0); PG8_MMA(0, 1, At, B1); PG8_BAR;
            PG8_LDA(At, 0, 1); PG8_STAGE(PG8_SA(0, 0), a2, voffA);
            PG8_BAR; PG8_WAIT_L(0); PG8_MMA(1, 0, At, B0); PG8_BAR; PG8_SCHED;
            PG8_STAGE(PG8_SB(0, 1), b2 + hstepB, voffB);
            PG8_WAIT_V(6); PG8_BAR; PG8_MMA(1, 1, At, B1); PG8_BAR;
            PG8_LDB(B0, 1, 0); PG8_SCHED; PG8_LDA(At, 1, 0); PG8_STAGE(PG8_SA(0, 1), a2 + hstepA, voffA);
            PG8_WAIT_L(8); PG8_BAR; PG8_WAIT_L(0); PG8_MMA(0, 0, At, B0); PG8_BAR; PG8_SCHED;
            PG8_LDB(B1, 1, 1); PG8_STAGE(PG8_SB(1, 0), b3, voffB);
            PG8_BAR; PG8_WAIT_L(0); PG8_MMA(0, 1, At, B1); PG8_BAR;
            PG8_LDA(At, 1, 1); PG8_STAGE(PG8_SA(1, 0), a3, voffA);
            PG8_BAR; PG8_WAIT_L(0); PG8_MMA(1, 0, At, B0); PG8_BAR; PG8_SCHED;
            PG8_STAGE(PG8_SB(1, 1), b3 + hstepB, voffB);
            PG8_WAIT_V(6); PG8_BAR; PG8_MMA(1, 1, At, B1); PG8_BAR;
        }
        if (Epi::ALIGN) { if (wr == 0) PG8_BAR; }
        E(acc, cur, wr, wc, fr, fq);
        if (Epi::ALIGN) { if (wr == 1) PG8_BAR; }
        if (!has_next) break;
#pragma unroll
        for (int a = 0; a < 2; ++a)
#pragma unroll
            for (int b = 0; b < 2; ++b)
#pragma unroll
                for (int m = 0; m < 4; ++m)
#pragma unroll
                    for (int n = 0; n < 2; ++n) acc[a][b][m][n] = (f32x4){0.f, 0.f, 0.f, 0.f};
        cur = nxt; cA = nA; cB = nB; ++ui;
    }
    PG8_WAIT_V(0);
    if (wr == 0) PG8_BAR;
    PG8_BAR;
#undef PG8_SA
#undef PG8_SB
#undef PG8_STAGE
#undef PG8_LDA
#undef PG8_LDB
#undef PG8_MMA
#undef PG8_WAIT_V
#undef PG8_WAIT_L
#undef PG8_BAR
#undef PG8_SCHED
}
}
using pg8::Gemm; using pg8::StaticOrder;

#define XB_TMO      128
#define XB_XCNT(j)  (256  + 64 * (j))
#define XB_XSUB(j)  (1280 + 64 * (j))
#define XB_XGEN(j)  (2304 + 64 * (j))
#define XB_TOP      3328
#define XB_TOPGEN   3392
#define XCD_BAR_WORDS 3456
#define XB_SPIN_CAP (1u << 20)
DI unsigned xb_ld(unsigned* p)              { return __hip_atomic_load(p, __ATOMIC_RELAXED, __HIP_MEMORY_SCOPE_AGENT); }
DI unsigned xb_add(unsigned* p, unsigned v) { return __hip_atomic_fetch_add(p, v, __ATOMIC_RELAXED, __HIP_MEMORY_SCOPE_AGENT); }
DI unsigned xb_xcc_id() { return (unsigned)__builtin_amdgcn_s_getreg((3 << 11) | 20) & 0xFu; }
#define XB_SPIN(cond, bar) do { unsigned _sp = 0; while (cond) { __builtin_amdgcn_s_sleep(1); \
    if ((++_sp & 255u) == 0u) { if (xb_ld(&(bar)[XB_TMO])) break; if (_sp > XB_SPIN_CAP) { atomicAdd(&(bar)[XB_TMO], 1u); break; } } } } while (0)
DI void xcd_barrier_post(unsigned* bar, volatile LAS unsigned* st) {
    if (threadIdx.x == 0) { const unsigned x = xb_xcc_id(); st[2] = x; (void)xb_add(&bar[XB_XCNT(x)], 1u); }
}
DI void xcd_barrier_complete(unsigned* bar, unsigned x, unsigned& nloc, unsigned& nx) {
    const unsigned G = gridDim.x;
    unsigned sum, cnt, mine, sp = 0u;
    for (;;) {
        sum = 0u; cnt = 0u; mine = 0u;
#pragma unroll
        for (unsigned j = 0; j < 16; ++j) { const unsigned c = xb_ld(&bar[XB_XCNT(j)]); sum += c; cnt += (c > 0u) ? 1u : 0u; mine = (j == x) ? c : mine; }
        if (sum == G) break;
        __builtin_amdgcn_s_sleep(1);
        if ((++sp & 255u) == 0u) { if (xb_ld(&bar[XB_TMO])) break; if (sp > XB_SPIN_CAP) { atomicAdd(&bar[XB_TMO], 1u); break; } }
    }
    nloc = mine > 0u ? mine : 1u; nx = cnt > 0u ? cnt : 1u;
}
DI void xcd_barrier(unsigned* bar, volatile LAS unsigned* st) {
    asm volatile("s_waitcnt vmcnt(0)" ::: "memory");
    __syncthreads();
    if (threadIdx.x == 0) {
        __builtin_amdgcn_s_waitcnt(0);
        unsigned nloc = st[0], nx = st[1]; const unsigned x = st[2];
        if (nloc == 0u) { xcd_barrier_complete(bar, x, nloc, nx); st[0] = nloc; st[1] = nx; }
        const unsigned old = xb_add(&bar[XB_XSUB(x)], 1u);
        const unsigned gen = old / nloc;
        if (old + 1u == (gen + 1u) * nloc) {
            __builtin_amdgcn_fence(__ATOMIC_RELEASE, "agent");
            asm volatile("s_waitcnt vmcnt(0)" ::: "memory");
            const unsigned og = xb_add(&bar[XB_TOP], 1u);
            const unsigned tg = og / nx;
            if (og + 1u == (tg + 1u) * nx) xb_add(&bar[XB_TOPGEN], 1u);
            else XB_SPIN(xb_ld(&bar[XB_TOPGEN]) == tg, bar);
            __builtin_amdgcn_fence(__ATOMIC_ACQUIRE, "agent");
            xb_add(&bar[XB_XGEN(x)], 1u);
            asm volatile("s_waitcnt vmcnt(0)" ::: "memory");
        } else {
            XB_SPIN(xb_ld(&bar[XB_XGEN(x)]) == gen, bar);
            __builtin_amdgcn_fence(__ATOMIC_ACQUIRE, "agent");
            asm volatile("s_waitcnt vmcnt(0)" ::: "memory");
        }
    }
    __syncthreads();
}

struct Params { const float* in[18]; float* out; unsigned char* ws; int ph_lo, ph_hi; };
struct Ctx {
    LAS unsigned long long* tab;
    DI unsigned long long raw(int i) const { const unsigned long long v = tab[i]; const unsigned lo = __builtin_amdgcn_readfirstlane((unsigned)v), hi = __builtin_amdgcn_readfirstlane((unsigned)(v >> 32)); return ((unsigned long long)hi << 32) | lo; }
    DI const float* in(int i) const { return (const float*)raw(i); }
    DI float* out() const { return (float*)raw(18); }
    DI unsigned char* wsp() const { return (unsigned char*)raw(19); }
};
enum { I_XP = 0, I_XS, I_WG, I_WU, I_WDN, I_LNG, I_LNB, I_ABI, I_ABO, I_DF, I_DB, I_CW, I_CDI, I_CDO, I_SLG, I_SLB, I_SW, I_SB };

#define MFMA16(a, b, c) __builtin_amdgcn_mfma_f32_16x16x32_bf16((a), (b), (c), 0, 0, 0)

DI void transpose_item(const float* src, int ld, bf16_t* dst, int K, int k0, int nsrc0, int drow0, LAS float* scr, int lane) {
    f32x2 v[16];
#pragma unroll
    for (int i = 0; i < 16; ++i) { const int kk = (lane >> 4) + 4 * i; v[i] = __builtin_nontemporal_load((const f32x2*)(src + (size_t)(k0 + kk) * ld + nsrc0 + (lane & 15) * 2)); }
#pragma unroll
    for (int i = 0; i < 16; ++i) { const int kk = (lane >> 4) + 4 * i; scr[kk * 33 + (lane & 15) * 2] = v[i][0]; scr[kk * 33 + (lane & 15) * 2 + 1] = v[i][1]; }
    LDS_WAIT();
    const int c = lane & 7;
#pragma unroll
    for (int j = 0; j < 4; ++j) { const int n = (lane >> 3) + 8 * j; const LAS float* s = scr + (8 * c) * 33 + n;
        u32x4 o; o.x = pk2(s[0 * 33], s[1 * 33]); o.y = pk2(s[2 * 33], s[3 * 33]); o.z = pk2(s[4 * 33], s[5 * 33]); o.w = pk2(s[6 * 33], s[7 * 33]);
        *(u32x4*)(dst + (size_t)(drow0 + n) * K + k0 + 8 * c) = o; }
    LDS_WAIT();
}
DI void phase_prep(const Ctx& p, LAS unsigned char* lds) {
    int tid_ = threadIdx.x; asm volatile("" : "+v"(tid_));
    const int tid = tid_, lane = tid & 63, wave = tid >> 6, G = gridDim.x;
    unsigned char* ws = p.wsp();
    LAS float* ctab = (LAS float*)(lds + 8 * 8448);
    for (int m = tid; m < 4096; m += 512) ctab[m] = cospif((float)m * (1.0f / 2048.0f));
    __syncthreads();
    {
        LAS float* scr = (LAS float*)(lds + wave * 8448);
        const int gw = blockIdx.x * 8 + wave, NGW = G * 8;
        constexpr int NI_FFN = 4 * 4224, NI_ABI = 1792, NI_SQ = 512;
        constexpr int NITEMS = NI_FFN + NI_ABI + 3 * NI_SQ;
        for (int it = gw; it < NITEMS; it += NGW) {
            int r = it;
            if (r < NI_FFN) {
                const int idx = r / 4224, r2 = r % 4224, which = r2 / 1408, item = r2 % 1408;
                if (which < 2) { const float* src = (which ? p.in(I_WU) : p.in(I_WG)) + (size_t)idx * 1024 * FF; const int kb = item / 88, nb = item % 88, n0 = nb * 32;
                    transpose_item(src, FF, (bf16_t*)(ws + WS_WGU + idx * SZ_WGU), 1024, kb * 64, n0, (n0 >> 7) * 256 + which * 128 + (n0 & 127), scr, lane); }
                else { const float* src = p.in(I_WDN) + (size_t)idx * FF * 1024; const int kb = item / 32, nb = item % 32;
                    transpose_item(src, 1024, (bf16_t*)(ws + WS_WD + idx * SZ_WD), FF, kb * 64, nb * 32, nb * 32, scr, lane); }
                continue;
            }
            r -= NI_FFN;
            if (r < NI_ABI) { const int kb = r / 112, nb = r % 112; transpose_item(p.in(I_ABI), ABN, (bf16_t*)(ws + WS_WABI), 1024, kb * 64, nb * 32, nb * 32, scr, lane); continue; }
            r -= NI_ABI;
            const int kb = (r % NI_SQ) / 32, nb = r % 32;
            if (r < NI_SQ) transpose_item(p.in(I_ABO), 1024, (bf16_t*)(ws + WS_WABO), 1024, kb * 64, nb * 32, nb * 32, scr, lane);
            else if (r < 2 * NI_SQ) transpose_item(p.in(I_CDI), 1536, (bf16_t*)(ws + WS_WUV), 1024, kb * 64, 512 + nb * 32, nb * 32, scr, lane);
            else transpose_item(p.in(I_CDO), 1024, (bf16_t*)(ws + WS_WCDO), 1024, kb * 64, nb * 32, nb * 32, scr, lane);
        }
    }
    const size_t gtid = (size_t)blockIdx.x * 512 + tid, NT = (size_t)G * 512;
    {
        bf16_t* xb = (bf16_t*)(ws + WS_XB);
        constexpr size_t NV = (size_t)T * D / 8;
        for (size_t e0 = gtid; e0 < NV; e0 += 4 * NT) {
            f32x4 a[4], b[4];
#pragma unroll
            for (int q = 0; q < 4; ++q) { const size_t e = e0 + q * NT; if (e < NV) { const size_t el = e * 8; const float* src = el < (size_t)TP * D ? p.in(I_XP) + el : p.in(I_XS) + (el - (size_t)TP * D);
                a[q] = __builtin_nontemporal_load((const f32x4*)src); b[q] = __builtin_nontemporal_load((const f32x4*)(src + 4)); } }
#pragma unroll
            for (int q = 0; q < 4; ++q) { const size_t e = e0 + q * NT; if (e < NV) { u32x4 o; o.x = pk2(a[q][0], a[q][1]); o.y = pk2(a[q][2], a[q][3]); o.z = pk2(b[q][0], b[q][1]); o.w = pk2(b[q][2], b[q][3]);
                *(u32x4*)(xb + e * 8) = o; } }
        }
    }
    {
        bf16_t* dft = (bf16_t*)(ws + WS_DFT);
        for (size_t e = gtid; e < (size_t)4096 * 512; e += NT) {
            const int r = (int)(e >> 9), s0 = (int)(e & 511) * 8, k = r & 2047; float v[8];
#pragma unroll
            for (int j = 0; j < 8; ++j) { const int m = (k * (s0 + j)) & 4095; v[j] = ctab[r < 2048 ? m : ((m - 1024) & 4095)]; }
            u32x4 o; o.x = pk2(v[0], v[1]); o.y = pk2(v[2], v[3]); o.z = pk2(v[4], v[5]); o.w = pk2(v[6], v[7]);
            *(u32x4*)(dft + (size_t)r * 4096 + s0) = o;
        }
    }
    {
        float* rc = (float*)(ws + WS_ROPE); float* rs = rc + 4096 * 64;
        for (size_t e = gtid; e < (size_t)4096 * 64; e += NT) {
            const int pos = (int)(e >> 6), i = (int)(e & 63);
            const float invf = exp2f(-(float)i * 0.2076205059304601f);
            const float ang = (float)pos * invf;
            const float nn = rintf(ang * 0.15915494309189535f);
            float r = fmaf(-nn, 6.2831854820251465f, ang); r = fmaf(-nn, -1.7484555e-7f, r);
            const float a = r * 0.3183098861837907f;
            rc[e] = cospif(a); rs[e] = sinpif(a);
        }
    }
    __syncthreads();
    {
        bf16_t* wf1 = (bf16_t*)(ws + WS_WF1); const float* W = p.in(I_CDI);
        LAS float* Wl = (LAS float*)lds;
        LAS f32x2* tw2 = (LAS f32x2*)(lds + 8320);
        if (tid < 128) tw2[tid] = (f32x2){ctab[tid * 32], ctab[(tid * 32 - 1024) & 4095]};
        for (int item = blockIdx.x; item < 256; item += G) {
            const int g = item & 3, d0 = (item >> 2) * 16;
            { const int dd = tid >> 5, c4 = tid & 31; const f32x4 w = *(const f32x4*)(W + (size_t)(d0 + dd) * 1536 + g * 128 + 4 * c4);
              Wl[dd * 129 + 4 * c4] = w[0]; Wl[dd * 129 + 4 * c4 + 1] = w[1]; Wl[dd * 129 + 4 * c4 + 2] = w[2]; Wl[dd * 129 + 4 * c4 + 3] = w[3]; }
            __syncthreads();
            const int dd = tid & 15, lb = tid >> 4;
            for (int k = 0; k < 3; ++k) {
                if (k == 2 && lb != 0) break;
                const int l = k == 2 ? 64 : lb + 32 * k; float ac = 0.f, as = 0.f; int m = 0;
#pragma unroll 8
                for (int c = 0; c < 128; ++c) { const f32x2 t = tw2[m]; const float w = Wl[dd * 129 + c]; ac += w * t[0]; as += w * t[1]; m = (m + l) & 127; }
                bf16_t* o = wf1 + (size_t)(g * 128) * 1024 + d0 + dd;
                o[(size_t)l * 1024] = f2bf(ac); o[(size_t)(512 + l) * 1024] = f2bf(-as);
                if (l > 0 && l < 64) { o[(size_t)(128 - l) * 1024] = f2bf(ac); o[(size_t)(512 + 128 - l) * 1024] = f2bf(as); }
            }
            __syncthreads();
        }
    }
    {
        bf16_t* sw = (bf16_t*)(ws + WS_SGUW);
        for (size_t e = gtid; e < (size_t)65536; e += NT) sw[e] = f2bf(p.in(I_SW)[e]);
    }
}

DI void phase_ln(float* x, bf16_t* xb, const float* g, const float* b, bool final_f32, int nrows = T) {
    int tid_ = threadIdx.x; asm volatile("" : "+v"(tid_));
    const int tid = tid_, lane = tid & 63, wave = tid >> 6;
    f32x4 g4[4], b4[4];
#pragma unroll
    for (int j = 0; j < 4; ++j) { g4[j] = ((const f32x4*)g)[lane + 64 * j]; b4[j] = ((const f32x4*)b)[lane + 64 * j]; }
    const int NW = gridDim.x * 8;
    for (int row0 = blockIdx.x * 8 + wave; row0 < nrows; row0 += 2 * NW) {
        const int row1 = row0 + NW; const bool has1 = row1 < nrows;
        f32x4* xr0 = (f32x4*)(x + (size_t)row0 * D) + lane; f32x4* xr1 = (f32x4*)(x + (size_t)(has1 ? row1 : row0) * D) + lane;
        f32x4 v[4], w[4]; float s = 0.f, s1 = 0.f;
#pragma unroll
        for (int j = 0; j < 4; ++j) { v[j] = xr0[64 * j]; w[j] = xr1[64 * j]; }
#pragma unroll
        for (int j = 0; j < 4; ++j) { s += (v[j][0] + v[j][1]) + (v[j][2] + v[j][3]); s1 += (w[j][0] + w[j][1]) + (w[j][2] + w[j][3]); }
#pragma unroll
        for (int o = 1; o < 64; o <<= 1) { s += __shfl_xor(s, o); s1 += __shfl_xor(s1, o); }
        const float mean = s * (1.0f / D), mean1 = s1 * (1.0f / D); float q = 0.f, q1 = 0.f;
#pragma unroll
        for (int j = 0; j < 4; ++j) { v[j] = v[j] - mean; q += (v[j][0] * v[j][0] + v[j][1] * v[j][1]) + (v[j][2] * v[j][2] + v[j][3] * v[j][3]);
            w[j] = w[j] - mean1; q1 += (w[j][0] * w[j][0] + w[j][1] * w[j][1]) + (w[j][2] * w[j][2] + w[j][3] * w[j][3]); }
#pragma unroll
        for (int o = 1; o < 64; o <<= 1) { q += __shfl_xor(q, o); q1 += __shfl_xor(q1, o); }
        const float rstd = 1.0f / sqrtf(q * (1.0f / D) + LN_EPS), rstd1 = 1.0f / sqrtf(q1 * (1.0f / D) + LN_EPS);
        u32x2* o8 = (u32x2*)(xb + (size_t)row0 * D) + lane; u32x2* o81 = (u32x2*)(xb + (size_t)row1 * D) + lane;
#pragma unroll
        for (int j = 0; j < 4; ++j) { const f32x4 y = v[j] * rstd * g4[j] + b4[j];
            if (final_f32) xr0[64 * j] = y; else { u32x2 t; t.x = pk2(y[0], y[1]); t.y = pk2(y[2], y[3]); o8[64 * j] = t; } }
        if (has1) {
#pragma unroll
            for (int j = 0; j < 4; ++j) { const f32x4 y = w[j] * rstd1 * g4[j] + b4[j];
                if (final_f32) xr1[64 * j] = y; else { u32x2 t; t.x = pk2(y[0], y[1]); t.y = pk2(y[2], y[3]); o81[64 * j] = t; } }
        }
    }
}

DI float log_sigmoid_f(float x) { return -log1pf(expf(-x)); }
constexpr int LP = 136;

template <bool TRANSPOSED>
DI void load_k_rot(const bf16_t* pj, int h, int n, const float* rc, const float* rs, LAS bf16_t* dst, int tid) {
#pragma unroll
    for (int it = 0; it < 2; ++it) {
        const int idx = tid + 512 * it; const int j = TRANSPOSED ? (idx & 127) : (idx >> 3), c8 = TRANSPOSED ? (idx >> 7) : (idx & 7);
        const bf16_t* kp = pj + (size_t)j * ABN + 512 + h * 128 + 8 * c8;
        const u32x4 k1 = *(const u32x4*)kp, k2 = *(const u32x4*)(kp + 64);
        const int pos = n * 128 + j; const float* cp = rc + pos * 64 + 8 * c8; const float* sp = rs + pos * 64 + 8 * c8;
        const f32x4 ca = *(const f32x4*)cp, cb = *(const f32x4*)(cp + 4), sa = *(const f32x4*)sp, sb = *(const f32x4*)(sp + 4);
        float o1[8], o2[8];
#pragma unroll
        for (int e = 0; e < 8; ++e) {
            const unsigned w1 = k1[e >> 1], w2 = k2[e >> 1]; const float t1 = (e & 1) ? bfhi(w1) : bflo(w1), t2 = (e & 1) ? bfhi(w2) : bflo(w2);
            const float c = e < 4 ? ca[e & 3] : cb[e & 3], s = e < 4 ? sa[e & 3] : sb[e & 3];
            o1[e] = (t1 * c - t2 * s) * KSCALE; o2[e] = (t2 * c + t1 * s) * KSCALE;
        }
        if (TRANSPOSED) {
#pragma unroll
            for (int e = 0; e < 8; ++e) { dst[(8 * c8 + e) * LP + j] = f2bf(o1[e]); dst[(64 + 8 * c8 + e) * LP + j] = f2bf(o2[e]); }
        } else {
            u32x4 a, b; a.x = pk2(o1[0], o1[1]); a.y = pk2(o1[2], o1[3]); a.z = pk2(o1[4], o1[5]); a.w = pk2(o1[6], o1[7]);
            b.x = pk2(o2[0], o2[1]); b.y = pk2(o2[2], o2[3]); b.z = pk2(o2[4], o2[5]); b.w = pk2(o2[6], o2[7]);
            *(LAS u32x4*)(dst + j * LP + 8 * c8) = a; *(LAS u32x4*)(dst + j * LP + 64 + 8 * c8) = b;
        }
    }
}
DI void load_tile_T(const bf16_t* src, int ld, LAS bf16_t* VT, int tid) {
#pragma unroll
    for (int it = 0; it < 4; ++it) {
        const int idx = tid + 512 * it, j = idx & 127, c = idx >> 7;
        const u32x4 v = *(const u32x4*)(src + (size_t)j * ld + 8 * c);
#pragma unroll
        for (int e = 0; e < 8; ++e) { const unsigned w = v[e >> 1]; VT[(8 * c + e) * LP + j] = (bf16_t)((e & 1) ? (w >> 16) : (w & 0xffffu)); }
    }
}

DI void tr_read8(unsigned addr, u32x2 (&r)[8]) {
    asm volatile("ds_read_b64_tr_b16 %0, %8\n\tds_read_b64_tr_b16 %1, %8 offset:1088\n\tds_read_b64_tr_b16 %2, %8 offset:8704\n\tds_read_b64_tr_b16 %3, %8 offset:9792\n\t"
                 "ds_read_b64_tr_b16 %4, %8 offset:17408\n\tds_read_b64_tr_b16 %5, %8 offset:18496\n\tds_read_b64_tr_b16 %6, %8 offset:26112\n\tds_read_b64_tr_b16 %7, %8 offset:27200\n\ts_waitcnt lgkmcnt(0)"
                 : "=&v"(r[0]), "=&v"(r[1]), "=&v"(r[2]), "=&v"(r[3]), "=&v"(r[4]), "=&v"(r[5]), "=&v"(r[6]), "=&v"(r[7]) : "v"(addr) : "memory");
}
DI void tr_read8b(unsigned addr, u32x2 (&r)[8]) {
    asm volatile("ds_read_b64_tr_b16 %0, %8\n\tds_read_b64_tr_b16 %1, %8 offset:4352\n\tds_read_b64_tr_b16 %2, %8 offset:8704\n\tds_read_b64_tr_b16 %3, %8 offset:13056\n\t"
                 "ds_read_b64_tr_b16 %4, %8 offset:17408\n\tds_read_b64_tr_b16 %5, %8 offset:21760\n\tds_read_b64_tr_b16 %6, %8 offset:26112\n\tds_read_b64_tr_b16 %7, %8 offset:30464\n\ts_waitcnt lgkmcnt(0)"
                 : "=&v"(r[0]), "=&v"(r[1]), "=&v"(r[2]), "=&v"(r[3]), "=&v"(r[4]), "=&v"(r[5]), "=&v"(r[6]), "=&v"(r[7]) : "v"(addr) : "memory");
}
static_assert(LP * 2 * 16 == 4352, "tr_read8b offsets assume the 136-element pitch");
static_assert(LP * 2 * 4 == 1088 && LP * 2 * 32 == 8704, "tr_read8 offsets assume the 136-element pitch");
DI void load_tile_rm(const bf16_t* src, int ld, LAS bf16_t* Vs, int tid) {
#pragma unroll
    for (int it = 0; it < 4; ++it) { const int idx = tid + 512 * it, j = idx >> 4, c = idx & 15; *(LAS u32x4*)(Vs + j * LP + 8 * c) = *(const u32x4*)(src + (size_t)j * ld + 8 * c); }
}

DI void phase_r1(const Ctx& p, LAS unsigned char* lds, int sl) {
    int tid_ = threadIdx.x; asm volatile("" : "+v"(tid_));
    const int tid = tid_, lane = tid & 63, wave = tid >> 6, l15 = lane & 15, quad = lane >> 4;
    unsigned char* ws = p.wsp();
    const bf16_t* PJ = (const bf16_t*)(ws + WS_S + S_PJ); bf16_t* KV = (bf16_t*)(ws + WS_S + S_KV);
    const float* rc = (const float*)(ws + WS_ROPE); const float* rs = rc + 4096 * 64;
    LAS bf16_t* KT = (LAS bf16_t*)lds; LAS bf16_t* VT = KT + 128 * LP;
    for (int u = blockIdx.x; u < 512; u += gridDim.x) {
        const int bl = u >> 7, n = (u >> 2) & 31, h = u & 3;
        const bf16_t* pj = PJ + (size_t)(bl * 4096 + n * 128) * ABN;
        load_k_rot<false>(pj, h, n, rc, rs, KT, tid);
        load_tile_rm(pj + 1024 + h * 128, ABN, VT, tid);
        __syncthreads();
        const float l2f = log_sigmoid_f(p.in(I_DF)[h]) * 1.4426950408889634f, l2b = log_sigmoid_f(p.in(I_DB)[h]) * 1.4426950408889634f;
        const unsigned trl = (unsigned)(((8 * quad + (l15 >> 2)) * LP + 4 * (l15 & 3)) * 2);
        bf16x8 Af[4], Ab[4];
        const float rF = exp2f(-l2f), rB = exp2f(l2b);
        {
            u32x2 vr[8]; tr_read8((unsigned)(128 * LP * 2) + trl + (unsigned)(16 * wave * 2), vr);
#pragma unroll
            for (int js = 0; js < 4; ++js) {
                const u32x4 raw = {vr[2 * js][0], vr[2 * js][1], vr[2 * js + 1][0], vr[2 * js + 1][1]};
                const int j0 = 32 * js + quad * 8;
                float kf = exp2f(l2f * (float)(127 - j0)), kb = exp2f(l2b * (float)j0);
                u32x4 pf, pb;
#pragma unroll
                for (int e2 = 0; e2 < 4; ++e2) { const float f0 = bflo(raw[e2]), f1 = bfhi(raw[e2]);
                    const float kf1 = kf * rF, kb1 = kb * rB;
                    pf[e2] = pk2(f0 * kf, f1 * kf1); pb[e2] = pk2(f0 * kb, f1 * kb1);
                    kf = kf1 * rF; kb = kb1 * rB; }
                Af[js] = __builtin_bit_cast(bf16x8, pf); Ab[js] = __builtin_bit_cast(bf16x8, pb);
            }
        }
        f32x4 accf[8], accb[8];
#pragma unroll
        for (int dt = 0; dt < 8; ++dt) { accf[dt] = (f32x4){0.f, 0.f, 0.f, 0.f}; accb[dt] = (f32x4){0.f, 0.f, 0.f, 0.f}; }
#pragma unroll
        for (int dt = 0; dt < 8; ++dt) {
            u32x2 kr[8]; tr_read8(trl + (unsigned)(16 * dt * 2), kr);
#pragma unroll
            for (int js = 0; js < 4; ++js) {
                const u32x4 kw = {kr[2 * js][0], kr[2 * js][1], kr[2 * js + 1][0], kr[2 * js + 1][1]};
                const bf16x8 kb = __builtin_bit_cast(bf16x8, kw);
                accf[dt] = MFMA16(kb, Af[js], accf[dt]); accb[dt] = MFMA16(kb, Ab[js], accb[dt]);
            }
        }
        bf16_t* kvf = KV + (size_t)(u * 2) * 16384 + (16 * wave + l15) * 128 + quad * 4; bf16_t* kvb = kvf + 16384;
#pragma unroll
        for (int dt = 0; dt < 8; ++dt) { u32x2 wf, wb; wf.x = pk2(accf[dt][0], accf[dt][1]); wf.y = pk2(accf[dt][2], accf[dt][3]); wb.x = pk2(accb[dt][0], accb[dt][1]); wb.y = pk2(accb[dt][2], accb[dt][3]);
            *(u32x2*)(kvf + 16 * dt) = wf; *(u32x2*)(kvb + 16 * dt) = wb; }
        __syncthreads();
    }
    {
        bf16_t* MX = (bf16_t*)p.out(); const float* cw = p.in(I_CW);
        const size_t gtid = (size_t)blockIdx.x * 512 + tid, NT = (size_t)gridDim.x * 512;
        for (size_t e0 = gtid; e0 < (size_t)SLAB * 64; e0 += 2 * NT) {
            u32x4 gb[2], gc[2], hc[2], gcl[2], hcl[2], gcr[2], hcr[2]; int tt[2], chh[2]; bool ok[2];
#pragma unroll
            for (int q = 0; q < 2; ++q) {
                const size_t e = e0 + q * NT; ok[q] = e < (size_t)SLAB * 64; const size_t ee = ok[q] ? e : e0;
                const int t = (int)(ee >> 6), ch = (int)(ee & 63) * 8, pos = t & 4095; tt[q] = t; chh[q] = ch;
                const bf16_t* r0 = PJ + (size_t)t * ABN;
                gb[q] = *(const u32x4*)(r0 + 2048 + ch); gc[q] = *(const u32x4*)(r0 + 2560 + ch); hc[q] = *(const u32x4*)(r0 + 3072 + ch);
                gcl[q] = (u32x4){0u, 0u, 0u, 0u}; hcl[q] = gcl[q]; gcr[q] = gcl[q]; hcr[q] = gcl[q];
                if (pos > 0) { gcl[q] = *(const u32x4*)(r0 - ABN + 2560 + ch); hcl[q] = *(const u32x4*)(r0 - ABN + 3072 + ch); }
                if (pos < 4095) { gcr[q] = *(const u32x4*)(r0 + ABN + 2560 + ch); hcr[q] = *(const u32x4*)(r0 + ABN + 3072 + ch); }
            }
#pragma unroll
            for (int q = 0; q < 2; ++q) {
                if (!ok[q]) continue;
                const int ch = chh[q]; float o[8];
#pragma unroll
                for (int jj = 0; jj < 8; ++jj) {
                    const int qq = jj >> 1; const bool hi = jj & 1;
                    const float zl = (hi ? bfhi(gcl[q][qq]) : bflo(gcl[q][qq])) * (hi ? bfhi(hcl[q][qq]) : bflo(hcl[q][qq]));
                    const float z0 = (hi ? bfhi(gc[q][qq]) : bflo(gc[q][qq])) * (hi ? bfhi(hc[q][qq]) : bflo(hc[q][qq]));
                    const float zr = (hi ? bfhi(gcr[q][qq]) : bflo(gcr[q][qq])) * (hi ? bfhi(hcr[q][qq]) : bflo(hcr[q][qq]));
                    const float cv = cw[ch + jj] * zl + cw[512 + ch + jj] * z0 + cw[1024 + ch + jj] * zr;
                    o[jj] = (hi ? bfhi(gb[q][qq]) : bflo(gb[q][qq])) * cv;
                }
                u32x4 w; w.x = pk2(o[0], o[1]); w.y = pk2(o[2], o[3]); w.z = pk2(o[4], o[5]); w.w = pk2(o[6], o[7]);
                *(u32x4*)(MX + (size_t)(sl * SLAB + tt[q]) * D + 512 + ch) = w;
            }
        }
    }
}

DI void phase_r2(const Ctx& p) {
    unsigned char* ws = p.wsp();
    const bf16_t* KV = (const bf16_t*)(ws + WS_S + S_KV); bf16_t* ST = (bf16_t*)(ws + WS_S + S_ST);
    int tid_ = threadIdx.x; asm volatile("" : "+v"(tid_));
    const size_t gtid = (size_t)blockIdx.x * 512 + tid_, NT = (size_t)gridDim.x * 512;
    for (size_t e = gtid; e < 131072; e += NT) {
        const int dir = (int)(e >> 16), bh = (int)(e >> 12) & 15, bl = bh >> 2, h = bh & 3, q4 = (int)(e & 4095);
        const float lg = log_sigmoid_f(dir ? p.in(I_DB)[h] : p.in(I_DF)[h]); const float cd = expf(128.0f * lg);
        f32x4 st = {0.f, 0.f, 0.f, 0.f};
        for (int s8 = 0; s8 < 32; s8 += 8) {
            f32x4 kv[8]; size_t off[8];
#pragma unroll
            for (int j = 0; j < 8; ++j) { const int step = s8 + j, n = dir ? 31 - step : step; const int u = (bl * 32 + n) * 4 + h; off[j] = (size_t)(u * 2 + dir) * 16384 + q4 * 4; { const u32x2 w = *(const u32x2*)(KV + off[j]); kv[j] = (f32x4){bflo(w.x), bfhi(w.x), bflo(w.y), bfhi(w.y)}; } }
#pragma unroll
            for (int j = 0; j < 8; ++j) { u32x2 w; w.x = pk2(st[0], st[1]); w.y = pk2(st[2], st[3]); *(u32x2*)(ST + off[j]) = w; st = st * cd + kv[j]; }
        }
    }
}

DI void phase_r3(const Ctx& p, LAS unsigned char* lds, int sl) {
    int tid_ = threadIdx.x; asm volatile("" : "+v"(tid_));
    const int tid = tid_, lane = tid & 63, wave = tid >> 6, l15 = lane & 15, quad = lane >> 4;
    unsigned char* ws = p.wsp();
    const bf16_t* PJ = (const bf16_t*)(ws + WS_S + S_PJ); const bf16_t* ST = (const bf16_t*)(ws + WS_S + S_ST);
    bf16_t* MX = (bf16_t*)p.out();
    const float* rc = (const float*)(ws + WS_ROPE); const float* rs = rc + 4096 * 64;
    LAS bf16_t* Ks = (LAS bf16_t*)lds; LAS bf16_t* VT = Ks + 128 * LP; LAS bf16_t* SFl = VT + 128 * LP; LAS bf16_t* SBl = SFl + 128 * LP;
    LAS float* DT = (LAS float*)(lds + LDS_LNS);
    for (int u = blockIdx.x; u < 512; u += gridDim.x) {
        const int bl = u >> 7, n = (u >> 2) & 31, h = u & 3;
        const int rowbase = bl * 4096 + n * 128;
        const bf16_t* pj = PJ + (size_t)rowbase * ABN;
        const bf16_t* stf = ST + (size_t)(u * 2) * 16384; const bf16_t* stb = stf + 16384;
        {
            u32x4 sv[8];
#pragma unroll
            for (int it = 0; it < 4; ++it) { const int idx = tid + 512 * it; sv[it] = *(const u32x4*)(stf + (idx >> 4) * 128 + (idx & 15) * 8); sv[4 + it] = *(const u32x4*)(stb + (idx >> 4) * 128 + (idx & 15) * 8); }
            load_k_rot<false>(pj, h, n, rc, rs, Ks, tid);
            load_tile_rm(pj + 1024 + h * 128, ABN, VT, tid);
#pragma unroll
            for (int it = 0; it < 4; ++it) { const int idx = tid + 512 * it; *(LAS u32x4*)(SFl + (idx >> 4) * LP + (idx & 15) * 8) = sv[it]; *(LAS u32x4*)(SBl + (idx >> 4) * LP + (idx & 15) * 8) = sv[4 + it]; }
        }
        const float l2f = log_sigmoid_f(p.in(I_DF)[h]) * 1.4426950408889634f, l2b = log_sigmoid_f(p.in(I_DB)[h]) * 1.4426950408889634f;
        if (tid < 256) DT[tid] = exp2f((tid < 128 ? l2f : l2b) * (float)(tid & 127));
        const int ii = 16 * wave + l15;
        bf16x8 Qa[4];
        {
            const bf16_t* qrow = pj + (size_t)ii * ABN + h * 128; const int pos = n * 128 + ii;
#pragma unroll
            for (int ks = 0; ks < 2; ++ks) {
                const int d0 = 32 * ks + quad * 8;
                const u32x4 q1 = *(const u32x4*)(qrow + d0), q2 = *(const u32x4*)(qrow + 64 + d0);
                const float* cp = rc + pos * 64 + d0; const float* sp = rs + pos * 64 + d0;
                const f32x4 ca = *(const f32x4*)cp, cb = *(const f32x4*)(cp + 4), sa = *(const f32x4*)sp, sb = *(const f32x4*)(sp + 4);
                u32x4 p1, p2;
#pragma unroll
                for (int e2 = 0; e2 < 4; ++e2) {
                    const float a1 = bflo(q1[e2]), b1 = bfhi(q1[e2]), a2 = bflo(q2[e2]), b2 = bfhi(q2[e2]);
                    const float c0 = e2 < 2 ? ca[2 * e2] : cb[2 * e2 - 4], c1 = e2 < 2 ? ca[2 * e2 + 1] : cb[2 * e2 - 3], s0 = e2 < 2 ? sa[2 * e2] : sb[2 * e2 - 4], s1 = e2 < 2 ? sa[2 * e2 + 1] : sb[2 * e2 - 3];
                    p1[e2] = pk2(a1 * c0 - a2 * s0, b1 * c1 - b2 * s1); p2[e2] = pk2(a2 * c0 + a1 * s0, b2 * c1 + b1 * s1);
                }
                Qa[ks] = __builtin_bit_cast(bf16x8, p1); Qa[ks + 2] = __builtin_bit_cast(bf16x8, p2);
            }
        }
        __syncthreads();
        bf16x8 Pb[4];
#pragma unroll
        for (int t = 0; t < 4; ++t) {
            f32x4 s0 = {0.f, 0.f, 0.f, 0.f}, s1 = {0.f, 0.f, 0.f, 0.f};
#pragma unroll
            for (int ks = 0; ks < 4; ++ks) {
                const bf16x8 k0 = *(const LAS bf16x8*)(Ks + (32 * t + l15) * LP + 32 * ks + quad * 8);
                const bf16x8 k1 = *(const LAS bf16x8*)(Ks + (32 * t + 16 + l15) * LP + 32 * ks + quad * 8);
                s0 = MFMA16(k0, Qa[ks], s0); s1 = MFMA16(k1, Qa[ks], s1);
            }
            float pm0[4], pm1[4];
#pragma unroll
            for (int r = 0; r < 4; ++r) {
                const int j0 = 32 * t + quad * 4 + r, j1 = j0 + 16; const int d0 = ii - j0, d1 = ii - j1;
                const float m0 = DT[d0 >= 0 ? d0 : 128 - d0], m1 = DT[d1 >= 0 ? d1 : 128 - d1];
                pm0[r] = s0[r] * m0; pm1[r] = s1[r] * m1;
            }
            { u32x4 pp; pp[0] = pk2(pm0[0], pm0[1]); pp[1] = pk2(pm0[2], pm0[3]); pp[2] = pk2(pm1[0], pm1[1]); pp[3] = pk2(pm1[2], pm1[3]); Pb[t] = __builtin_bit_cast(bf16x8, pp); }
        }
        const float rf = exp2f(l2f * (float)(ii + 1)), rb = exp2f(l2b * (float)(128 - ii));
        f32x4 O[8];
#pragma unroll
        for (int vt = 0; vt < 8; ++vt) {
            f32x4 aF = {0.f, 0.f, 0.f, 0.f}, aB = {0.f, 0.f, 0.f, 0.f};
#pragma unroll
            for (int ks = 0; ks < 4; ++ks) {
                const bf16x8 sf = *(const LAS bf16x8*)(SFl + (16 * vt + l15) * LP + 32 * ks + quad * 8);
                const bf16x8 sb = *(const LAS bf16x8*)(SBl + (16 * vt + l15) * LP + 32 * ks + quad * 8);
                aF = MFMA16(sf, Qa[ks], aF); aB = MFMA16(sb, Qa[ks], aB);
            }
            f32x4 o = aF * rf + aB * rb;
            {
                u32x2 vr[8]; tr_read8b((unsigned)(128 * LP * 2) + (unsigned)(((4 * quad + (l15 >> 2)) * LP + 4 * (l15 & 3)) * 2) + (unsigned)(16 * vt * 2), vr);
#pragma unroll
                for (int t = 0; t < 4; ++t) {
                    const u32x4 aw = {vr[2 * t][0], vr[2 * t][1], vr[2 * t + 1][0], vr[2 * t + 1][1]};
                    o = MFMA16(__builtin_bit_cast(bf16x8, aw), Pb[t], o);
                }
            }
            O[vt] = o;
        }
        float s = 0.f;
#pragma unroll
        for (int vt = 0; vt < 8; ++vt) s += (O[vt][0] + O[vt][1]) + (O[vt][2] + O[vt][3]);
        s += __shfl_xor(s, 16); s += __shfl_xor(s, 32);
        const float mean = s * (1.0f / 128.0f); float q = 0.f;
#pragma unroll
        for (int vt = 0; vt < 8; ++vt) { O[vt] = O[vt] - mean; q += (O[vt][0] * O[vt][0] + O[vt][1] * O[vt][1]) + (O[vt][2] * O[vt][2] + O[vt][3] * O[vt][3]); }
        q += __shfl_xor(q, 16); q += __shfl_xor(q, 32);
        const float rstd = 1.0f / sqrtf(q * (1.0f / 128.0f) + LN_EPS);
        const bf16_t* grow = pj + (size_t)ii * ABN + 1536 + h * 128 + quad * 4;
        bf16_t* orow = MX + (size_t)(sl * SLAB + rowbase + ii) * D + h * 128 + quad * 4;
        u32x2 gwv[8];
#pragma unroll
        for (int vt = 0; vt < 8; ++vt) gwv[vt] = *(const u32x2*)(grow + 16 * vt);
#pragma unroll
        for (int vt = 0; vt < 8; ++vt) {
            const u32x2 gw = gwv[vt];
            const float g0 = bflo(gw.x), g1 = bfhi(gw.x), g2 = bflo(gw.y), g3 = bfhi(gw.y);
            const f32x4 y = O[vt] * rstd;
            u32x2 w; w.x = pk2(pg8::silu_f(g0) * y[0], pg8::silu_f(g1) * y[1]); w.y = pk2(pg8::silu_f(g2) * y[2], pg8::silu_f(g3) * y[3]);
            *(u32x2*)(orow + 16 * vt) = w;
        }
        __syncthreads();
    }
}

DI void phase_sgu(const Ctx& p, LAS unsigned char* lds, int c0, int cG, int uend) {
    int tid_ = threadIdx.x; asm volatile("" : "+v"(tid_));
    const int tid = tid_, lane = tid & 63, wave = tid >> 6, l15 = lane & 15, quad = lane >> 4;
    unsigned char* ws = p.wsp();
    const bf16_t* UV = (const bf16_t*)(ws + WS_S + S_UV); const bf16_t* SW = (const bf16_t*)(ws + WS_SGUW);
    bf16_t* MX = (bf16_t*)p.out();
    LAS bf16_t* VT = (LAS bf16_t*)lds;
    const int j = tid >> 2, part = tid & 3, ii = 16 * wave + l15;
    for (int u = c0; u < uend; u += cG) {
        const int tok0 = u * 128;
        const bf16_t* vp = UV + (size_t)(tok0 + j) * D + 512 + part * 128;
        u32x4 v[16];
#pragma unroll
        for (int c = 0; c < 16; ++c) v[c] = *(const u32x4*)(vp + 8 * c);
        bf16x8 Wb[4][4];
#pragma unroll
        for (int g = 0; g < 4; ++g)
#pragma unroll
            for (int js = 0; js < 4; ++js) Wb[g][js] = *(const bf16x8*)(SW + (size_t)(g * 128 + ii) * 128 + 32 * js + quad * 8);
        float s = 0.f, q = 0.f;
#pragma unroll
        for (int c = 0; c < 16; ++c)
#pragma unroll
            for (int e = 0; e < 4; ++e) { const float a = bflo(v[c][e]), b = bfhi(v[c][e]); s += a + b; q += a * a + b * b; }
        s += __shfl_xor(s, 1); s += __shfl_xor(s, 2); q += __shfl_xor(q, 1); q += __shfl_xor(q, 2);
        const float mean = s * (1.0f / 512.0f); const float rstd = 1.0f / sqrtf(fmaxf(q * (1.0f / 512.0f) - mean * mean, 0.f) + LN_EPS);
        {
            LAS bf16_t* vt = VT + part * VTS + j;
#pragma unroll
            for (int c = 0; c < 16; ++c)
#pragma unroll
                for (int e = 0; e < 8; ++e) { const unsigned w = v[c][e >> 1]; const float x = (e & 1) ? bfhi(w) : bflo(w); vt[(8 * c + e) * LP] = f2bf((x - mean) * rstd); }
        }
        __syncthreads();
#pragma unroll
        for (int g = 0; g < 4; ++g) {
            float rsw = 0.f;
#pragma unroll
            for (int js = 0; js < 4; ++js)
#pragma unroll
                for (int e = 0; e < 8; ++e) rsw += bf2f((unsigned short)Wb[g][js][e]);
            rsw += __shfl_xor(rsw, 16); rsw += __shfl_xor(rsw, 32);
            const float bias = p.in(I_SB)[g * 128 + ii];
            const float* lg = p.in(I_SLG) + g * 128 + quad * 4; const float* lb = p.in(I_SLB) + g * 128 + quad * 4;
            const bf16_t* urow = UV + (size_t)(tok0 + ii) * D + g * 128 + quad * 4;
            bf16_t* orow = MX + (size_t)(tok0 + ii) * D + 512 + g * 128 + quad * 4;
            u32x2 uwv[8]; f32x4 gvv[8], bvv[8];
#pragma unroll
            for (int ct = 0; ct < 8; ++ct) { uwv[ct] = *(const u32x2*)(urow + 16 * ct); gvv[ct] = *(const f32x4*)(lg + 16 * ct); bvv[ct] = *(const f32x4*)(lb + 16 * ct); }
#pragma unroll
            for (int ct = 0; ct < 8; ++ct) {
                const u32x2 uw = uwv[ct];
                const f32x4 gv = gvv[ct], bv = bvv[ct];
                f32x4 acc = {0.f, 0.f, 0.f, 0.f};
#pragma unroll
                for (int js = 0; js < 4; ++js) { const bf16x8 a = *(const LAS bf16x8*)(VT + g * VTS + (16 * ct + l15) * LP + 32 * js + quad * 8); acc = MFMA16(a, Wb[g][js], acc); }
                const f32x4 sg = acc * gv + bv * rsw + bias;
                u32x2 w; w.x = pk2(bflo(uw.x) * sg[0], bfhi(uw.x) * sg[1]); w.y = pk2(bflo(uw.y) * sg[2], bfhi(uw.y) * sg[3]);
                *(u32x2*)(orow + 16 * ct) = w;
            }
        }
        __syncthreads();
    }
}

DI void run_phase(const Ctx& p, LAS unsigned char* lds, int ph) {
    unsigned char* ws = p.wsp();
    int G = gridDim.x, c = blockIdx.x; asm volatile("" : "+s"(G), "+s"(c));
    bf16_t* XB = (bf16_t*)(ws + WS_XB);
    StaticOrder S;
    int ffn = -1, sub = 0;
    if (ph >= 1 && ph <= 3) { ffn = 0; sub = ph - 1; }
    else if (ph >= 18 && ph <= 20) { ffn = 1; sub = ph - 18; }
    else if (ph >= 21 && ph <= 23) { ffn = 2; sub = ph - 21; }
    else if (ph >= 28 && ph <= 30) { ffn = 3; sub = ph - 28; }
    if (ph == 0) { phase_prep(p, lds); return; }
    if (ffn >= 0) {
        const int lnidx = (ffn == 0) ? 0 : (ffn == 1) ? 2 : (ffn == 2) ? 3 : 5;
        if (sub == 0) {
            Gemm g{XB, (const bf16_t*)(ws + WS_WGU + ffn * SZ_WGU), T, 5632, 1024, 1024, 1024}; S.init(g.M, g.N, G, c);
            pg8::EpiSwiglu E{(bf16_t*)(ws + WS_S + S_H)}; pg8::gemm_phase(lds, g, S, E);
        } else if (sub == 1) {
            Gemm g{(const bf16_t*)(ws + WS_S + S_H), (const bf16_t*)(ws + WS_WD + ffn * SZ_WD), T, 1024, FF, FF, FF}; S.init(g.M, g.N, G, c, 1);
            unsigned long long* st = (unsigned long long*)(ws + WS_LNS); const unsigned cn = (unsigned)lnidx + 1u;
            const float* gm = p.in(I_LNG) + lnidx * D; const float* bt = p.in(I_LNB) + lnidx * D;
            if (ffn == 0) { pg8::EpiLn<0> E{p.in(I_XP), p.in(I_XS), XB, 0.5f, gm, bt, st, cn, lds}; pg8::gemm_phase(lds, g, S, E); }
            else if (ffn == 3) { pg8::EpiLn<2> E{XB, XB, p.out(), 0.5f, gm, bt, st, cn, lds}; pg8::gemm_phase(lds, g, S, E); }
            else { pg8::EpiLn<1> E{XB, XB, XB, 0.5f, gm, bt, st, cn, lds}; pg8::gemm_phase(lds, g, S, E); }
        }
        return;
    }
    if (ph >= 4 && ph <= 15) {
        const int sl = (ph - 4) >> 2, k = (ph - 4) & 3;
        if (k == 0) { Gemm g{XB + (size_t)sl * SLAB * D, (const bf16_t*)(ws + WS_WABI), SLAB, ABN, 1024, 1024, 1024}; S.init(g.M, g.N, G, c);
            pg8::EpiBf16<0> E{(bf16_t*)(ws + WS_S + S_PJ), ABN}; pg8::gemm_phase(lds, g, S, E); }
        else if (k == 1) phase_r1(p, lds, sl);
        else if (k == 2) phase_r2(p);
        else phase_r3(p, lds, sl);
        return;
    }
    if (ph == 16 || ph == 26) {
        Gemm g{(const bf16_t*)p.out(), (const bf16_t*)(ws + (ph == 16 ? WS_WABO : WS_WCDO)), T, 1024, 1024, 1024, 1024}; S.init(g.M, g.N, G, c, 1);
        const int lnidx = ph == 16 ? 1 : 4;
        pg8::EpiLn<1> E{XB, XB, XB, 1.0f, p.in(I_LNG) + lnidx * D, p.in(I_LNB) + lnidx * D, (unsigned long long*)(ws + WS_LNS), (unsigned)lnidx + 1u, lds}; pg8::gemm_phase(lds, g, S, E); return;
    }
    if (ph == 24) {
        { Gemm g{(const bf16_t*)(ws + WS_WF1), XB, 1024, T, 1024, 1024, 1024}; S.init(g.M, g.N, G, c); pg8::EpiF1 E{(bf16_t*)(ws + WS_S + S_GT)}; pg8::gemm_phase(lds, g, S, E); }
        { Gemm g{XB, (const bf16_t*)(ws + WS_WUV), T, 1024, 1024, 1024, 1024}; S.init(g.M, g.N, G, c); pg8::EpiBf16<1> E{(bf16_t*)(ws + WS_S + S_UV), 1024}; pg8::gemm_phase(lds, g, S, E); }
        return;
    }
    if (ph == 25) {
        {   Gemm g{(const bf16_t*)(ws + WS_DFT), (const bf16_t*)(ws + WS_S + S_GT), 4096, 6144, 4096, 4096, 8192};
            pg8::F2Order FO{G, c}; pg8::EpiF2 E{(bf16_t*)p.out(), (float*)(ws + WS_S + S_F2P) + (size_t)c * 65536}; pg8::gemm_phase(lds, g, FO, E); }
        if (G == 256) { if (c >= 192) phase_sgu(p, lds, c - 192, 64, 384); }
        else phase_sgu(p, lds, c, G, 384);
        const int c0 = c, cG = G;
        if (c0 >= 0) {
            int tq = threadIdx.x; asm volatile("" : "+v"(tq)); const int lane = tq & 63, wave = tq >> 6; const bf16_t* GT = (const bf16_t*)(ws + WS_S + S_GT); bf16_t* MX = (bf16_t*)p.out();
            for (int col = c0 * 8 + wave; col < 6144; col += cG * 8) {
                const u32x4* gp = (const u32x4*)(GT + (size_t)col * 8192) + lane; float sacc = 0.f;
#pragma unroll
                for (int j = 0; j < 8; ++j) { const u32x4 v = gp[64 * j];
#pragma unroll
                    for (int e = 0; e < 4; ++e) sacc += bflo(v[e]) - bfhi(v[e]); }
#pragma unroll
                for (int o = 1; o < 64; o <<= 1) sacc += __shfl_xor(sacc, o);
                if (lane == 0) MX[(size_t)((col >> 9) * 4096 + 2048) * 1024 + (col & 511)] = f2bf(sacc * FSCALE);
            }
        }
        return;
    }
}

__global__ void __launch_bounds__(512, 2) fwd_megakernel(Params p) {
    extern __shared__ __attribute__((aligned(16))) unsigned char lds_raw[];
    LAS unsigned char* lds = (LAS unsigned char*)lds_raw;
    cg::grid_group grid = cg::this_grid();
    Ctx C; C.tab = (LAS unsigned long long*)(lds + LDS_MISC);
    volatile LAS unsigned* xst = (volatile LAS unsigned*)(lds + LDS_MISC + 512);
    if (threadIdx.x == 0) {
#pragma unroll
        for (int i = 0; i < 18; ++i) C.tab[i] = (unsigned long long)p.in[i];
        C.tab[18] = (unsigned long long)p.out; C.tab[19] = (unsigned long long)p.ws;
        xst[0] = 0u; xst[1] = 0u; xst[2] = 0u;
    }
    __syncthreads();
    xcd_barrier_post((unsigned*)(p.ws + WS_BAR), xst);
    const int ph_hi = p.ph_hi;
    for (int ph = p.ph_lo; ph < ph_hi; ++ph) {
        if (ph == 3 || ph == 17 || ph == 20 || ph == 23 || ph == 27 || ph == 30) continue;
        run_phase(C, lds, ph);
        if (ph + 1 < ph_hi) {
            if (ph_hi < 0) grid.sync();
            else xcd_barrier((unsigned*)(C.wsp() + WS_BAR), xst);
        }
    }
}

extern "C" void kernel_launch(void* const* d_in, const int* in_sizes, int n_in, void* d_out, int out_size, void* d_ws, size_t ws_size, hipStream_t stream) {
    static int grid_blocks = 0;
    if (grid_blocks == 0) {
        if (n_in != 18 || out_size != T * D || ws_size < WS_END) { fprintf(stderr, "kernel_launch: unexpected shapes (n_in %d out %d ws %zu need %zu)\n", n_in, out_size, ws_size, (size_t)WS_END); grid_blocks = -1; return; }
        int dev = 0, cus = 0, per_cu = 0;
        hipGetDevice(&dev);
        hipDeviceGetAttribute(&cus, hipDeviceAttributeMultiprocessorCount, dev);
        if (hipFuncSetAttribute((const void*)fwd_megakernel, hipFuncAttributeMaxDynamicSharedMemorySize, LDS_BYTES) != hipSuccess) { fprintf(stderr, "kernel_launch: hipFuncSetAttribute failed\n"); grid_blocks = -1; return; }
        hipOccupancyMaxActiveBlocksPerMultiprocessor(&per_cu, (const void*)fwd_megakernel, 512, LDS_BYTES);
        if (per_cu < 1) { fprintf(stderr, "kernel_launch: occupancy query says %d blocks per CU\n", per_cu); per_cu = 1; }
        grid_blocks = cus;
        if (cus != 256) fprintf(stderr, "kernel_launch: built for 256 CUs (the fused LayerNorm epilogues pair workgroups by round); this device reports %d\n", cus);
    }
    if (grid_blocks < 0) return;
    if (hipMemsetAsync((char*)d_ws + WS_BAR, 0, ZERO_BYTES, stream) != hipSuccess || hipMemsetAsync((char*)d_ws + WS_LNS, 0, ZERO2_BYTES, stream) != hipSuccess) { fprintf(stderr, "kernel_launch: memset failed\n"); return; }
    Params p{};
    for (int i = 0; i < 18; ++i) p.in[i] = (const float*)d_in[i];
    p.out = (float*)d_out; p.ws = (unsigned char*)d_ws;
    p.ph_lo = 0; p.ph_hi = NPHASE;
    void* args[] = {&p};
    hipError_t e = hipLaunchCooperativeKernel((const void*)fwd_megakernel, dim3(grid_blocks), dim3(512), args, LDS_BYTES, stream);
    if (e != hipSuccess) fprintf(stderr, "cooperative launch failed: %s (grid %d)\n", hipGetErrorString(e), grid_blocks);
}
```
